# Optimizing an MI355X kernel written in HIP

```python
import math
import jax, jax.numpy as jnp
from jax import lax
import numpy as np

D_MODEL = 1024
BATCH = 8
SEQ = 4096
DEPTH = 4

NSA_HEADS = 8
NSA_KV_GROUPS = 2
NSA_HPG = NSA_HEADS // NSA_KV_GROUPS
NSA_HEAD_DIM = 64
N_BRANCH = 3
CMP_BLOCK = 32
CMP_STRIDE = 16
CMP_HIDDEN = 256
SLC_BLOCK = 64
SLC_TOP_N = 16
WINDOW = 512
NSA_Q_BLOCK = 64
ROPE_THETA = 500000.0
ROPE_DIM = NSA_HEAD_DIM // 4

GDN_HEADS = 4
GDN_HEAD_DIM = 128
GDN_CONV = 4
GDN_CHUNK = 64

NSA_WIDTH = NSA_HEADS * NSA_HEAD_DIM
GDN_WIDTH = GDN_HEADS * GDN_HEAD_DIM
MIX_WIDTH = NSA_WIDTH + GDN_WIDTH
NSA_KV_WIDTH = N_BRANCH * 2 * NSA_KV_GROUPS * NSA_HEAD_DIM
NSA_GATE_WIDTH = NSA_HEADS * N_BRANCH
IN_SPLITS = (NSA_WIDTH, NSA_KV_WIDTH, NSA_GATE_WIDTH, 3 * GDN_WIDTH, GDN_HEADS, GDN_HEADS, GDN_WIDTH)
IN_WIDTH = sum(IN_SPLITS)

D_FF = 2816
FFN_CONV = 3
NORM_EPS = 1e-6

kernel_name = "hybrid_nsa_gdn_convffn_trunk"


def rms_norm(x, gain):
    xf = x.astype(jnp.float32)
    y = xf * lax.rsqrt(jnp.mean(xf * xf, axis=-1, keepdims=True) + NORM_EPS)
    return (y * gain.astype(jnp.float32)).astype(x.dtype)


def l2_norm(x):
    xf = x.astype(jnp.float32)
    return xf * lax.rsqrt(jnp.sum(xf * xf, axis=-1, keepdims=True) + NORM_EPS)


def split_columns(t, sizes):
    bounds = np.cumsum(sizes)[:-1].tolist()
    return jnp.split(t, bounds, axis=-1)


def rope_tables(positions):
    inv = ROPE_THETA ** (-jnp.arange(0, ROPE_DIM, 2, dtype=jnp.float32) / ROPE_DIM)
    ang = positions.astype(jnp.float32)[..., None] * inv
    return jnp.cos(ang), jnp.sin(ang)


def apply_partial_rope(x, cos, sin):
    half = ROPE_DIM // 2
    x1 = x[..., :half].astype(jnp.float32)
    x2 = x[..., half:ROPE_DIM].astype(jnp.float32)
    c = cos[:, :, None, :]
    s = sin[:, :, None, :]
    rot = jnp.concatenate([x1 * c - x2 * s, x2 * c + x1 * s], axis=-1).astype(x.dtype)
    return jnp.concatenate([rot, x[..., ROPE_DIM:]], axis=-1)


def masked_softmax(scores, mask):
    s = jnp.where(mask, scores.astype(jnp.float32), -jnp.inf)
    m = jnp.max(s, axis=-1, keepdims=True)
    m = jnp.where(jnp.isfinite(m), m, 0.0)
    p = jnp.exp(s - m)
    return p / jnp.maximum(jnp.sum(p, axis=-1, keepdims=True), 1e-30)


def causal_dwconv(x, w):
    width, T = w.shape[0], x.shape[1]
    xp = jnp.pad(x, ((0, 0), (width - 1, 0), (0, 0)))
    out = xp[:, 0:T] * w[0]
    for j in range(1, width):
        out = out + xp[:, j:j + T] * w[j]
    return out


def compress_blocks(x, pe, w1, w2):
    B, G, T, DH = x.shape
    n_cmp = (T - CMP_BLOCK) // CMP_STRIDE + 1
    idx = jnp.arange(n_cmp)[:, None] * CMP_STRIDE + jnp.arange(CMP_BLOCK)[None, :]
    blocks = (x[:, :, idx] + pe).reshape(B, G, n_cmp, CMP_BLOCK * DH)
    return jax.nn.silu(blocks @ w1) @ w2


def nsa_mixer(q, kv, gate_logits, cos, sin, q_gain, k_gain, cmp_pe, cmp_w1, cmp_w2, out_gain):
    B, T, _ = q.shape
    dt = q.dtype
    G, HPG, DH = NSA_KV_GROUPS, NSA_HPG, NSA_HEAD_DIM
    q = q.reshape(B, T, NSA_HEADS, DH)
    q = apply_partial_rope(rms_norm(q, q_gain), cos, sin) * (DH ** -0.5)
    q = q.reshape(B, T, G, HPG, DH).transpose(0, 2, 3, 1, 4)
    gates = jax.nn.sigmoid(gate_logits).reshape(B, T, G, HPG, N_BRANCH).transpose(0, 2, 3, 1, 4)
    kv = kv.reshape(B, T, N_BRANCH, 2, G, DH)

    def heads_first(t):
        return t.transpose(0, 2, 1, 3)

    k_cmp = rms_norm(compress_blocks(heads_first(apply_partial_rope(kv[:, :, 0, 0], cos, sin)),
                                     cmp_pe[0], cmp_w1[0], cmp_w2[0]), k_gain[0])
    v_cmp = compress_blocks(heads_first(kv[:, :, 0, 1]), cmp_pe[1], cmp_w1[1], cmp_w2[1])
    k_slc = heads_first(apply_partial_rope(rms_norm(kv[:, :, 1, 0], k_gain[1]), cos, sin))
    v_slc = heads_first(kv[:, :, 1, 1])
    k_win = heads_first(apply_partial_rope(rms_norm(kv[:, :, 2, 0], k_gain[2]), cos, sin))
    v_win = heads_first(kv[:, :, 2, 1])

    n_cmp = k_cmp.shape[2]
    n_slc = T // SLC_BLOCK
    n_top = min(SLC_TOP_N, n_slc)
    cmp_start = jnp.arange(n_cmp) * CMP_STRIDE
    cmp_end = cmp_start + CMP_BLOCK - 1
    slc_start = jnp.arange(n_slc) * SLC_BLOCK
    overlap = ((cmp_start[:, None] < slc_start[None, :] + SLC_BLOCK)
               & (cmp_start[:, None] + CMP_BLOCK > slc_start[None, :])).astype(jnp.float32)
    k_slc_blocks = k_slc.reshape(B, G, n_slc, SLC_BLOCK, DH)
    v_slc_blocks = v_slc.reshape(B, G, n_slc, SLC_BLOCK, DH)
    k_win_pad = jnp.pad(k_win, ((0, 0), (0, 0), (WINDOW, 0), (0, 0)))
    v_win_pad = jnp.pad(v_win, ((0, 0), (0, 0), (WINDOW, 0), (0, 0)))
    b_ix = jnp.arange(B)[:, None, None, None]
    g_ix = jnp.arange(G)[None, :, None, None]
    blk_offsets = jnp.arange(SLC_BLOCK)
    win_offsets = jnp.arange(NSA_Q_BLOCK + WINDOW)

    def block_fn(qb):
        t0 = qb * NSA_Q_BLOCK
        t_idx = t0 + jnp.arange(NSA_Q_BLOCK)
        q_b = lax.dynamic_slice_in_dim(q, t0, NSA_Q_BLOCK, axis=3)
        g_b = lax.dynamic_slice_in_dim(gates, t0, NSA_Q_BLOCK, axis=3)
        p_c = masked_softmax(jnp.einsum('bghqd,bgnd->bghqn', q_b, k_cmp), cmp_end[None, :] <= t_idx[:, None])
        o_c = jnp.einsum('bghqn,bgnd->bghqd', p_c.astype(dt), v_cmp)
        imp = jnp.einsum('bghqn,ns->bgqs', p_c, overlap)
        cur = (t_idx // SLC_BLOCK)[:, None]
        j = jnp.arange(n_slc)[None, :]
        forced = (j == 0) | (j == cur) | (j == cur - 1)
        imp = jnp.where(forced, jnp.inf, jnp.where(j > cur, -jnp.inf, imp))
        _, sel = lax.top_k(imp, n_top)
        k_s = k_slc_blocks[b_ix, g_ix, sel].reshape(B, G, NSA_Q_BLOCK, n_top * SLC_BLOCK, DH)
        v_s = v_slc_blocks[b_ix, g_ix, sel].reshape(B, G, NSA_Q_BLOCK, n_top * SLC_BLOCK, DH)
        pos_s = (sel[..., None] * SLC_BLOCK + blk_offsets).reshape(B, G, NSA_Q_BLOCK, n_top * SLC_BLOCK)
        mask_s = (pos_s <= t_idx[None, None, :, None])[:, :, None]
        p_s = masked_softmax(jnp.einsum('bghqd,bgqkd->bghqk', q_b, k_s), mask_s)
        o_s = jnp.einsum('bghqk,bgqkd->bghqd', p_s.astype(dt), v_s)
        k_w = lax.dynamic_slice_in_dim(k_win_pad, t0, NSA_Q_BLOCK + WINDOW, axis=2)
        v_w = lax.dynamic_slice_in_dim(v_win_pad, t0, NSA_Q_BLOCK + WINDOW, axis=2)
        pos_w = t0 - WINDOW + win_offsets
        rel = t_idx[:, None] - pos_w[None, :]
        mask_w = (rel >= 0) & (rel < WINDOW) & (pos_w[None, :] >= 0)
        p_w = masked_softmax(jnp.einsum('bghqd,bgkd->bghqk', q_b, k_w), mask_w)
        o_w = jnp.einsum('bghqk,bgkd->bghqd', p_w.astype(dt), v_w)
        return g_b[..., 0:1] * o_c + g_b[..., 1:2] * o_s + g_b[..., 2:3] * o_w

    out = lax.map(block_fn, jnp.arange(T // NSA_Q_BLOCK))
    out = out.transpose(1, 0, 4, 2, 3, 5).reshape(B, T, NSA_HEADS, DH)
    return rms_norm(out, out_gain).reshape(B, T, NSA_WIDTH)


def gated_delta_rule_chunked(q, k, v, g, beta):
    B, T, H, DK = q.shape
    DV = v.shape[-1]
    C = GDN_CHUNK
    N = T // C
    f32 = jnp.float32

    def chunks(t):
        return t.astype(f32).reshape(B, N, C, H, -1).transpose(1, 0, 3, 2, 4)

    qc = chunks(q) * (DK ** -0.5)
    kc = chunks(k)
    vc = chunks(v)
    gc = chunks(g[..., None])[..., 0]
    bc = chunks(beta[..., None])[..., 0]
    gcum = jnp.cumsum(gc, axis=-1)
    causal = jnp.tril(jnp.ones((C, C), bool))
    strict = jnp.tril(jnp.ones((C, C), bool), -1)
    decay = jnp.exp(jnp.where(causal, gcum[..., :, None] - gcum[..., None, :], -jnp.inf))
    kb = kc * bc[..., None]
    vb = vc * bc[..., None]
    a_kk = jnp.where(strict, jnp.einsum('nbhid,nbhjd->nbhij', kb, kc) * decay, 0.0)
    eye = jnp.eye(C, dtype=f32)
    t_inv = lax.linalg.triangular_solve(a_kk + eye, jnp.broadcast_to(eye, a_kk.shape),
                                        left_side=True, lower=True, unit_diagonal=True)
    u = jnp.einsum('nbhij,nbhjd->nbhid', t_inv, vb)
    w = jnp.einsum('nbhij,nbhjd->nbhid', t_inv, kb * jnp.exp(gcum)[..., None])
    a_qk = jnp.einsum('nbhid,nbhjd->nbhij', qc, kc) * decay

    def step(S, xs):
        q_i, k_i, u_i, w_i, a_i, g_i = xs
        v_new = u_i - jnp.einsum('bhcd,bhde->bhce', w_i, S)
        o_i = (jnp.einsum('bhcd,bhde->bhce', q_i * jnp.exp(g_i)[..., None], S)
               + jnp.einsum('bhij,bhje->bhie', a_i, v_new))
        g_last = g_i[..., -1]
        S = (S * jnp.exp(g_last)[..., None, None]
             + jnp.einsum('bhcd,bhce->bhde', k_i * jnp.exp(g_last[..., None] - g_i)[..., None], v_new))
        return S, o_i

    S0 = jnp.zeros((B, H, DK, DV), f32)
    _, o = lax.scan(step, S0, (qc, kc, u, w, a_qk, gcum))
    return o.transpose(1, 0, 3, 2, 4).reshape(B, T, H, DV)


def gdn_mixer(qkv, a_in, b_in, z, conv_w, a_log, dt_bias, out_gain):
    B, T, _ = qkv.shape
    dt = qkv.dtype
    qkv = jax.nn.silu(causal_dwconv(qkv, conv_w))
    q, k, v = jnp.split(qkv, 3, axis=-1)
    q = l2_norm(q.reshape(B, T, GDN_HEADS, GDN_HEAD_DIM))
    k = l2_norm(k.reshape(B, T, GDN_HEADS, GDN_HEAD_DIM))
    v = v.reshape(B, T, GDN_HEADS, GDN_HEAD_DIM)
    beta = jax.nn.sigmoid(b_in.astype(jnp.float32))
    g = -jnp.exp(a_log.astype(jnp.float32)) * jax.nn.softplus(a_in.astype(jnp.float32) + dt_bias.astype(jnp.float32))
    o = gated_delta_rule_chunked(q, k, v, g, beta)
    o = rms_norm(o, out_gain) * jax.nn.silu(z.astype(jnp.float32).reshape(B, T, GDN_HEADS, GDN_HEAD_DIM))
    return o.astype(dt).reshape(B, T, GDN_WIDTH)


def conv_glu_ffn(h, w_up, conv_w, conv_b, w_down):
    u = causal_dwconv(h @ w_up, conv_w) + conv_b
    gate, up = jnp.split(u, 2, axis=-1)
    return (jax.nn.silu(gate) * up) @ w_down


def setup_inputs(seed: int = 0) -> dict:
    key = jax.random.key(seed)
    ks = jax.random.split(key, 24)
    f32 = jnp.float32

    def nrm(k, shape, scale):
        return scale * jax.random.normal(k, shape, f32)

    def gain(k, shape):
        return 1.0 + 0.02 * jax.random.normal(k, shape, f32)

    res = (2 * DEPTH) ** -0.5
    dt_init = jnp.exp(jax.random.uniform(ks[12], (DEPTH, GDN_HEADS), f32, math.log(1e-3), math.log(1e-1)))
    positions = (jax.random.randint(ks[1], (BATCH, 1), 0, 1024, jnp.int32)
                 + jnp.arange(SEQ, dtype=jnp.int32)[None, :])
    return {
        "x": nrm(ks[0], (BATCH, SEQ, D_MODEL), 1.0),
        "positions": positions,
        "attn_norm": gain(ks[2], (DEPTH, D_MODEL)),
        "w_in": nrm(ks[3], (DEPTH, D_MODEL, IN_WIDTH), D_MODEL ** -0.5),
        "nsa_q_norm": gain(ks[4], (DEPTH, NSA_HEAD_DIM)),
        "nsa_k_norm": gain(ks[5], (DEPTH, N_BRANCH, NSA_HEAD_DIM)),
        "cmp_pe": nrm(ks[6], (DEPTH, 2, CMP_BLOCK, NSA_HEAD_DIM), 0.1),
        "cmp_w1": nrm(ks[7], (DEPTH, 2, CMP_BLOCK * NSA_HEAD_DIM, CMP_HIDDEN), (CMP_BLOCK * NSA_HEAD_DIM) ** -0.5),
        "cmp_w2": nrm(ks[8], (DEPTH, 2, CMP_HIDDEN, NSA_HEAD_DIM), CMP_HIDDEN ** -0.5),
        "nsa_out_norm": gain(ks[9], (DEPTH, NSA_HEADS, NSA_HEAD_DIM)),
        "gdn_conv_w": nrm(ks[10], (DEPTH, GDN_CONV, 3 * GDN_WIDTH), GDN_CONV ** -0.5),
        "gdn_a_log": jnp.log(jax.random.uniform(ks[11], (DEPTH, GDN_HEADS), f32, 1.0, 16.0)),
        "gdn_dt_bias": dt_init + jnp.log(-jnp.expm1(-dt_init)),
        "gdn_out_norm": gain(ks[13], (DEPTH, GDN_HEAD_DIM)),
        "w_out": nrm(ks[14], (DEPTH, MIX_WIDTH, D_MODEL), res * MIX_WIDTH ** -0.5),
        "ffn_norm": gain(ks[15], (DEPTH, D_MODEL)),
        "w_up": nrm(ks[16], (DEPTH, D_MODEL, 2 * D_FF), D_MODEL ** -0.5),
        "ffn_conv_w": nrm(ks[17], (DEPTH, FFN_CONV, 2 * D_FF), FFN_CONV ** -0.5),
        "ffn_conv_b": nrm(ks[18], (DEPTH, 2 * D_FF), 0.01),
        "w_down": nrm(ks[19], (DEPTH, D_FF, D_MODEL), res * D_FF ** -0.5),
    }


def reference(x, positions, attn_norm, w_in, nsa_q_norm, nsa_k_norm, cmp_pe, cmp_w1, cmp_w2, nsa_out_norm,
              gdn_conv_w, gdn_a_log, gdn_dt_bias, gdn_out_norm, w_out, ffn_norm, w_up, ffn_conv_w,
              ffn_conv_b, w_down):
    cos, sin = rope_tables(positions)
    for l in range(DEPTH):
        h = rms_norm(x, attn_norm[l])
        proj = h @ w_in[l]
        nsa_q, nsa_kv, nsa_g, gdn_qkv, gdn_a, gdn_b, gdn_z = split_columns(proj, IN_SPLITS)
        o_nsa = nsa_mixer(nsa_q, nsa_kv, nsa_g, cos, sin, nsa_q_norm[l], nsa_k_norm[l],
                          cmp_pe[l], cmp_w1[l], cmp_w2[l], nsa_out_norm[l])
        o_gdn = gdn_mixer(gdn_qkv, gdn_a, gdn_b, gdn_z, gdn_conv_w[l], gdn_a_log[l],
                          gdn_dt_bias[l], gdn_out_norm[l])
        x = x + jnp.concatenate([o_nsa, o_gdn], axis=-1) @ w_out[l]
        h = rms_norm(x, ffn_norm[l])
        x = x + conv_glu_ffn(h, w_up[l], ffn_conv_w[l], ffn_conv_b[l], w_down[l])
    return x
```

```cpp
#include <hip/hip_runtime.h>
#include <hip/hip_cooperative_groups.h>
#include <cstdio>
#include <cstdint>
namespace cg = cooperative_groups;

typedef _Float16 half_t;
typedef _Float16 h8 __attribute__((ext_vector_type(8)));
typedef _Float16 h4 __attribute__((ext_vector_type(4)));
typedef float f32x4 __attribute__((ext_vector_type(4)));
typedef float f32x16 __attribute__((ext_vector_type(16)));
#define DI __device__ __forceinline__

constexpr int M_ = 32768, T_ = 4096, D_ = 1024, PL = 3584, NFF = 2816;
constexpr int NTH = 512;
constexpr int LDS_BYTES = 163840;
constexpr float EPS = 1e-6f;

constexpr size_t AL(size_t x) { return (x + 255) & ~(size_t)255; }
constexpr size_t WS_WIN = 0;
constexpr size_t WS_WOUT = WS_WIN + AL((size_t)PL * 1024 * 2);
constexpr size_t WS_WUP = WS_WOUT + AL((size_t)1024 * 1024 * 2);
constexpr size_t WS_WDOWN = WS_WUP + AL((size_t)5632 * 1024 * 2);
constexpr size_t WS_WC1 = WS_WDOWN + AL((size_t)1024 * 2816 * 2);
constexpr size_t WS_C1P = WS_WC1 + AL((size_t)2 * 256 * 2048 * 2);
constexpr size_t WS_COS = WS_C1P + AL((size_t)16 * 512 * 4);
constexpr size_t WS_SIN = WS_COS + AL((size_t)M_ * 8 * 4);
constexpr size_t WS_RSS = WS_SIN + AL((size_t)M_ * 8 * 4);
constexpr size_t WS_XH = WS_RSS + AL((size_t)M_ * 4 * 4);
constexpr size_t WS_PROJ = WS_XH + AL((size_t)(M_ + 264) * 1024 * 2);
constexpr size_t WS_KCR = WS_PROJ + AL((size_t)M_ * PL * 2);
constexpr size_t WS_VCR = WS_KCR + AL(((size_t)16 * 4096 * 64 + 4096) * 2);
constexpr size_t WS_HID = WS_VCR + AL(((size_t)16 * 4096 * 64 + 4096) * 2);
constexpr size_t WS_KC = WS_HID + AL((size_t)2 * 4096 * 256 * 2);
constexpr size_t WS_VCT = WS_KC + AL((size_t)16 * 256 * 64 * 2);
constexpr size_t WS_VST = WS_VCT + AL((size_t)16 * 256 * 64 * 2);
constexpr size_t WS_VWT = WS_VST + AL((size_t)16 * 64 * 4096 * 2);
constexpr size_t WS_WG = WS_VWT + AL((size_t)16 * 64 * 4096 * 2);
constexpr size_t WS_QG = WS_WG + AL((size_t)M_ * 512 * 2);
constexpr size_t WS_UG = WS_QG + AL((size_t)M_ * 512 * 2);
constexpr size_t WS_KTG = WS_UG + AL((size_t)M_ * 512 * 2);
constexpr size_t WS_AQK = WS_KTG + AL((size_t)2048 * 128 * 64 * 2);
constexpr size_t WS_GL = WS_AQK + AL((size_t)2048 * 64 * 64 * 2);
constexpr size_t WS_END = WS_GL + AL((size_t)2048 * 4);

__constant__ float ROPE_INV[8] = {1.000000000e+00f,1.939227432e-01f,3.760603070e-02f,7.292664610e-03f,1.414213562e-03f,2.742481884e-04f,5.318295734e-05f,1.031338525e-05f};

constexpr size_t WSET_STRIDE = AL(WS_COS + 65536);
constexpr size_t WS_HF = WS_WG + 4 * WSET_STRIDE;
constexpr size_t WS_HL = WS_HF + AL((size_t)128 * 2 * 5632 * 2);
static_assert(WS_HL + (size_t)128 * 2 * 5632 * 2 <= WS_AQK, "halo buffers must fit the free region");
DI size_t wset(int l) { return WS_WG + (size_t)l * WSET_STRIDE; }
DI size_t w2t_off(int l) { return WS_WG + (size_t)l * WSET_STRIDE + WS_COS; }

struct Params {
  const float* x; const int* pos; const float* attn_norm; const float* w_in; const float* q_norm; const float* k_norm;
  const float* cmp_pe; const float* cmp_w1; const float* cmp_w2; const float* nsa_out_norm; const float* gdn_conv_w;
  const float* gdn_a_log; const float* gdn_dt_bias; const float* gdn_out_norm; const float* w_out; const float* ffn_norm;
  const float* w_up; const float* ffn_conv_w; const float* ffn_conv_b; const float* w_down;
  float* out; char* ws; int phase_lo; int phase_hi;
};

DI float sigm(float x) { return 1.f / (1.f + expf(-x)); }
DI float siluf(float x) { return x / (1.f + expf(-x)); }
DI float silu_fast(float x) { return x * __frcp_rn(1.f + __expf(-x)); }
DI f32x16 mfma32(h8 a, h8 b, f32x16 c) { return __builtin_amdgcn_mfma_f32_32x32x16_f16(a, b, c, 0, 0, 0); }
DI f32x4 mfma16(h8 a, h8 b, f32x4 c) { return __builtin_amdgcn_mfma_f32_16x16x32_f16(a, b, c, 0, 0, 0); }
DI h8 cat44(h4 a, h4 b) { return __builtin_shufflevector(a, b, 0, 1, 2, 3, 4, 5, 6, 7); }
DI char* lws(const Params& p) { char* w = p.ws; asm volatile("" : "+s"(w)); return w; }
DI int ltid() { int t = threadIdx.x; asm volatile("" : "+v"(t)); return t; }
typedef _Float16 h2 __attribute__((ext_vector_type(2)));
#define EXP2(x) __builtin_amdgcn_exp2f(x)
DI int crow(int reg, int hf) { return (reg & 3) + 8 * (reg >> 2) + 4 * hf; }

DI int map_in(int c) {
  if (c < 512) return c;
  if (c < 1024) return 2848 + (c - 512);
  if (c < 1792) return 512 + (c - 1024);
  if (c < 3328) return 1304 + (c - 1792);
  if (c < 3352) return 1280 + (c - 3328);
  if (c < 3360) return 2840 + (c - 3352);
  return -1;
}
DI int map_up(int c) { int n = c >> 8, j = c & 255; return j < 128 ? n * 128 + j : 2816 + n * 128 + (j - 128); }

template <int MAP>
__device__ void conv_transpose(const float* __restrict__ W, int K, int No, half_t* __restrict__ Wt, int Np, char* smem, const float* __restrict__ rs = nullptr) {
  float* tile = (float*)smem;
  const int tid = ltid();
  const int ntn = Np / 64, ntk = K / 64;
  for (int t = blockIdx.x; t < ntn * ntk; t += gridDim.x) {
    int tn = t % ntn, tk = t / ntn;
#pragma unroll
    for (int e = 0; e < 8; ++e) {
      int idx = tid + NTH * e; int kk = idx >> 6, nn = idx & 63;
      int np = tn * 64 + nn;
      int on = MAP == 1 ? map_in(np) : (MAP == 2 ? map_up(np) : np);
      float v = on >= 0 ? W[(size_t)(tk * 64 + kk) * No + on] : 0.f;
      if (rs) v *= rs[tk * 64 + kk];
      tile[kk * 65 + nn] = v;
    }
    __syncthreads();
    {
      int nn = tid >> 3, kg = tid & 7; h8 v;
#pragma unroll
      for (int j = 0; j < 8; ++j) v[j] = (half_t)tile[(kg * 8 + j) * 65 + nn];
      *(h8*)(Wt + (size_t)(tn * 64 + nn) * K + tk * 64 + kg * 8) = v;
    }
    __syncthreads();
  }
}

__device__ void phase_weights(const Params& p, int l, char* smem) {
  char* ws = p.ws + wset(l);
  conv_transpose<1>(p.w_in + (size_t)l * 1024 * 3360, 1024, 3360, (half_t*)(ws + WS_WIN), PL, smem, p.attn_norm + l * 1024);
  conv_transpose<0>(p.w_out + (size_t)l * 1024 * 1024, 1024, 1024, (half_t*)(ws + WS_WOUT), 1024, smem);
  conv_transpose<2>(p.w_up + (size_t)l * 1024 * 5632, 1024, 5632, (half_t*)(ws + WS_WUP), 5632, smem, p.ffn_norm + l * 1024);
  conv_transpose<0>(p.w_down + (size_t)l * 2816 * 1024, 2816, 1024, (half_t*)(ws + WS_WDOWN), 1024, smem);
  for (int kv = 0; kv < 2; ++kv)
    conv_transpose<0>(p.cmp_w1 + (size_t)(l * 2 + kv) * 2048 * 256, 2048, 256, (half_t*)(ws + WS_WC1) + (size_t)kv * 256 * 2048, 256, smem);
  for (int kv = 0; kv < 2; ++kv)
    conv_transpose<0>(p.cmp_w2 + (size_t)(l * 2 + kv) * 256 * 64, 256, 64, (half_t*)(p.ws + w2t_off(l)) + (size_t)kv * 64 * 256, 64, smem);
  float* c1p = (float*)(ws + WS_C1P);
  for (int it = blockIdx.x; it < 32; it += gridDim.x) {
    int kv = it >> 4, kc = it & 15; int n = ltid();
    if (n < 256) {
      const float* pe = p.cmp_pe + (size_t)(l * 2 + kv) * 2048 + kc * 128;
      const float* w1 = p.cmp_w1 + ((size_t)(l * 2 + kv) * 2048 + kc * 128) * 256 + n;
      float s = 0.f;
      for (int k = 0; k < 128; ++k) s += pe[k] * w1[(size_t)k * 256];
      c1p[kc * 512 + kv * 256 + n] = s;
    }
  }
  if (l == 0) {
    half_t* xh = (half_t*)(p.ws + WS_XH + 8192); float* rss = (float*)(p.ws + WS_RSS);
    float* cs = (float*)(p.ws + WS_COS); float* sn = (float*)(p.ws + WS_SIN);
    const int tidw = ltid(); const int wid = tidw >> 6, lane = tidw & 63;
    for (int row = blockIdx.x * 8 + wid; row < M_; row += gridDim.x * 8) {
      const float* xr = p.x + (size_t)row * 1024;
      float ss = 0.f;
#pragma unroll
      for (int e = 0; e < 2; ++e) {
        int c = (e * 64 + lane) * 8;
        float4 a = *(const float4*)(xr + c), b = *(const float4*)(xr + c + 4);
        float4 ga = {1.f, 1.f, 1.f, 1.f}, gb = {1.f, 1.f, 1.f, 1.f};
        ss += a.x * a.x + a.y * a.y + a.z * a.z + a.w * a.w + b.x * b.x + b.y * b.y + b.z * b.z + b.w * b.w;
        h8 v; v[0] = (half_t)(a.x * ga.x); v[1] = (half_t)(a.y * ga.y); v[2] = (half_t)(a.z * ga.z); v[3] = (half_t)(a.w * ga.w);
        v[4] = (half_t)(b.x * gb.x); v[5] = (half_t)(b.y * gb.y); v[6] = (half_t)(b.z * gb.z); v[7] = (half_t)(b.w * gb.w);
        *(h8*)(xh + (size_t)row * 1024 + c) = v;
      }
#pragma unroll
      for (int o = 32; o >= 1; o >>= 1) ss += __shfl_xor(ss, o);
      if (lane == 0) { float4 r; r.x = ss; r.y = 0.f; r.z = 0.f; r.w = 0.f; *(float4*)(rss + (size_t)row * 4) = r; }
      if (lane < 8) {
        float inv = ROPE_INV[lane];
        float ang = (float)p.pos[row] * inv;
        cs[(size_t)row * 8 + lane] = cosf(ang);
        sn[(size_t)row * 8 + lane] = sinf(ang);
      }
    }
  }
}

DI int lds_byte(int r, int c) {
  int st = (r >> 4) * 2 + (c >> 5), rr = r & 15, cc = c & 31, ob = rr * 64 + cc * 2;
  return st * 1024 + (ob ^ (((ob >> 9) & 1) << 5));
}
DI void stage_rc(int b, int& R, int& C) {
  int st = b / 1024, sb = b % 1024, swz = sb ^ (((sb >> 9) & 1) << 5);
  R = (st >> 1) * 16 + swz / 64; C = (st & 1) * 32 + (swz % 64) / 2;
}

DI void gemm_kloop(const half_t* __restrict__ A0, const half_t* __restrict__ A1, const half_t* __restrict__ Bt0, const half_t* __restrict__ Bt1,
                   const unsigned (&oa)[2], const unsigned (&ob)[2], int nt, char* smem, f32x4 (&acc)[2][2][4][2], const int tid) {
  const int wid = tid >> 6, lane = tid & 63, wr = wid >> 2, wc = wid & 3, fr = lane & 15, fq = lane >> 4;
  constexpr int HTB = 128 * 64 * 2;
#define SA(b, h) (smem + ((b) * 2 + (h)) * HTB)
#define SB(b, h) (smem + (4 + (b) * 2 + (h)) * HTB)
#define STAGE(P, BASE, O, kt) do { for (int _i = 0; _i < 2; ++_i) { \
    __builtin_amdgcn_global_load_lds((const unsigned*)((BASE) + (long)(kt) * 64 + (O)[_i]), (unsigned*)((P) + tid * 16 + _i * 8192), 16, 0, 0); } } while (0)
#define LDA(dst, b, h) for (int m = 0; m < 4; ++m) for (int k = 0; k < 2; ++k) \
    dst[m][k] = *reinterpret_cast<const h8*>(SA(b, h) + lds_byte(wr * 64 + m * 16 + fr, k * 32 + fq * 8))
#define LDB(dst, b, h) for (int n = 0; n < 2; ++n) for (int k = 0; k < 2; ++k) \
    dst[n][k] = *reinterpret_cast<const h8*>(SB(b, h) + lds_byte(wc * 32 + n * 16 + fr, k * 32 + fq * 8))
#define MMA(ai, bj, At_, Bt_) do { __builtin_amdgcn_s_setprio(1); \
    for (int m = 0; m < 4; ++m) for (int n = 0; n < 2; ++n) for (int k = 0; k < 2; ++k) \
      acc[ai][bj][m][n] = mfma16(Bt_[n][k], At_[m][k], acc[ai][bj][m][n]); \
    __builtin_amdgcn_s_setprio(0); } while (0)
#define WAIT_V(n) asm volatile("s_waitcnt vmcnt(" #n ")" ::: "memory")
#define WAIT_L(n) asm volatile("s_waitcnt lgkmcnt(" #n ")" ::: "memory")
#define BAR __builtin_amdgcn_s_barrier()
#define SCHED __builtin_amdgcn_sched_barrier(0)
  h8 At[4][2], B0[2][2], B1[2][2];
#pragma unroll
  for (int a = 0; a < 2; ++a) for (int b = 0; b < 2; ++b) for (int m = 0; m < 4; ++m) for (int n = 0; n < 2; ++n) acc[a][b][m][n] = f32x4{0.f, 0.f, 0.f, 0.f};
  STAGE(SB(0, 0), Bt0, ob, 0); STAGE(SA(0, 0), A0, oa, 0);
  STAGE(SB(0, 1), Bt1, ob, 0); STAGE(SA(0, 1), A1, oa, 0);
  if (wr == 1) BAR;
  WAIT_V(4); BAR;
  STAGE(SB(1, 0), Bt0, ob, 1); STAGE(SA(1, 0), A0, oa, 1); STAGE(SB(1, 1), Bt1, ob, 1);
  WAIT_V(6); BAR;
  for (int t = 0; t < nt - 2; t += 2) {
    LDB(B0, 0, 0); SCHED; LDA(At, 0, 0); STAGE(SA(1, 1), A1, oa, t + 1);
    WAIT_L(8); BAR; WAIT_L(0); MMA(0, 0, At, B0); BAR; SCHED;
    LDB(B1, 0, 1); STAGE(SB(0, 0), Bt0, ob, t + 2);
    BAR; WAIT_L(0); MMA(0, 1, At, B1); BAR;
    LDA(At, 0, 1); STAGE(SA(0, 0), A0, oa, t + 2);
    BAR; WAIT_L(0); MMA(1, 0, At, B0); BAR; SCHED;
    STAGE(SB(0, 1), Bt1, ob, t + 2);
    WAIT_V(6); BAR; MMA(1, 1, At, B1); BAR;
    LDB(B0, 1, 0); SCHED; LDA(At, 1, 0); STAGE(SA(0, 1), A1, oa, t + 2);
    WAIT_L(8); BAR; WAIT_L(0); MMA(0, 0, At, B0); BAR; SCHED;
    LDB(B1, 1, 1); STAGE(SB(1, 0), Bt0, ob, t + 3);
    BAR; WAIT_L(0); MMA(0, 1, At, B1); BAR;
    LDA(At, 1, 1); STAGE(SA(1, 0), A0, oa, t + 3);
    BAR; WAIT_L(0); MMA(1, 0, At, B0); BAR; SCHED;
    STAGE(SB(1, 1), Bt1, ob, t + 3);
    WAIT_V(6); BAR; MMA(1, 1, At, B1); BAR;
  }
  { LDB(B0, 0, 0); LDA(At, 0, 0); STAGE(SA(1, 1), A1, oa, nt - 1);
    BAR; WAIT_L(0); MMA(0, 0, At, B0); BAR;
    LDB(B1, 0, 1); BAR; WAIT_L(0); MMA(0, 1, At, B1); BAR;
    LDA(At, 0, 1); WAIT_V(4); BAR; WAIT_L(0); MMA(1, 0, At, B0); MMA(1, 1, At, B1); BAR; }
  { LDB(B0, 1, 0); LDA(At, 1, 0); WAIT_V(2); BAR; WAIT_L(0); MMA(0, 0, At, B0); BAR;
    LDB(B1, 1, 1); WAIT_V(0); BAR; WAIT_L(0); MMA(0, 1, At, B1); BAR;
    LDA(At, 1, 1); BAR; WAIT_L(0); MMA(1, 0, At, B0); MMA(1, 1, At, B1); BAR; }
  if (wr == 0) BAR;
#undef SA
#undef SB
#undef STAGE
#undef LDA
#undef LDB
#undef MMA
#undef WAIT_V
#undef WAIT_L
#undef BAR
#undef SCHED
}

enum { EPI_IN = 0, EPI_RES = 1, EPI_UP = 2, EPI_CMP = 3 };
struct GArgs {
  const half_t* A; long lda; const half_t* Bt; int K; int nM; int nN;
  const float* rss; half_t* outh; long ldo;
  const float* resid; float* xout; const float* gain_next; float* rss_out;
  const float* convw; const float* convb; const float* c1p;
  const float* cs; const float* sn; const float* qg; const float* kg1; const float* kg2;
  half_t* kcr; half_t* vcr; half_t* vst; half_t* vwt;
  const half_t* w2t; half_t* kc; half_t* vct; const float* kg0; int kv;
  half_t* hf; half_t* hl;
};

constexpr int TS = 264;

DI void tile_copy_out(const char* smem, half_t* out, long ldo, long grow0, int gcol0, int tid) {
#pragma unroll
  for (int e = 0; e < 16; ++e) {
    int id = tid + NTH * e; int row = id >> 5, c16 = id & 31;
    h8 v = *(const h8*)(smem + (row * TS + c16 * 8) * 2);
    *(h8*)(out + (grow0 + row) * ldo + gcol0 + c16 * 8) = v;
  }
}

template <int EPI>
__device__ void gemm_tile(const GArgs& g, int pm, int pn, char* smem) {
  int tid = ltid();
  const long brow = (long)pm * 256;
  const int bcol = pn * 256;
  if (EPI == EPI_RES) {
    if (g.convw && (pm & 15) != 0) {
      const half_t* L = g.hl + (size_t)(pm - 1) * 2 * 5632; const half_t* F = g.hf + (size_t)pm * 2 * 5632;
      for (int idx = tid; idx < 2816; idx += NTH) {
        int pnn = idx >> 7, cc = idx & 127; int gcol = pnn * 256 + cc, ucol = gcol + 128;
        float wg0 = g.convw[idx], wg1 = g.convw[5632 + idx], wg2 = g.convw[2 * 5632 + idx];
        float wu0 = g.convw[2816 + idx], wu1 = g.convw[5632 + 2816 + idx], wu2 = g.convw[2 * 5632 + 2816 + idx];
        float bgv = g.convb[idx], buv = g.convb[2816 + idx];
        float L0g = (float)L[gcol], L1g = (float)L[5632 + gcol], F0g = (float)F[gcol], F1g = (float)F[5632 + gcol];
        float L0u = (float)L[ucol], L1u = (float)L[5632 + ucol], F0u = (float)F[ucol], F1u = (float)F[5632 + ucol];
        float y0g = wg2 * F0g + wg1 * L1g + wg0 * L0g + bgv, y0u = wu2 * F0u + wu1 * L1u + wu0 * L0u + buv;
        float y1g = wg2 * F1g + wg1 * F0g + wg0 * L1g + bgv, y1u = wu2 * F1u + wu1 * F0u + wu0 * L1u + buv;
        half_t* act = (half_t*)g.A;
        act[brow * NFF + idx] = (half_t)(silu_fast(y0g) * y0u);
        act[(brow + 1) * NFF + idx] = (half_t)(silu_fast(y1g) * y1u);
      }
      asm volatile("s_waitcnt vmcnt(0)" ::: "memory");
      __syncthreads();
    }
  }
  unsigned oa[2], ob[2];
#pragma unroll
  for (int i = 0; i < 2; ++i) {
    int R, C; stage_rc(tid * 16 + i * 8192, R, C);
    oa[i] = (unsigned)(R * (int)g.lda + C);
    ob[i] = (unsigned)(R * g.K + C);
  }
  f32x4 acc[2][2][4][2];
  gemm_kloop(g.A + brow * g.lda, g.A + (brow + 128) * g.lda, g.Bt + (long)bcol * g.K, g.Bt + (long)(bcol + 128) * g.K, oa, ob, g.K / 64, smem, acc, tid);
  __syncthreads();
  asm volatile("" : "+v"(tid));
  const int wid = tid >> 6, lane = tid & 63, wr = wid >> 2, wc = wid & 3, fr = lane & 15, fq = lane >> 4;
  float* aux = (float*)(smem + 256 * TS * 2);

  if (EPI == EPI_IN || EPI == EPI_UP) {
    float rs[2][4];
#pragma unroll
    for (int ai = 0; ai < 2; ++ai)
#pragma unroll
      for (int m = 0; m < 4; ++m) {
        long gr = brow + ai * 128 + wr * 64 + m * 16 + fr;
        gr = gr < 0 ? 0 : (gr > M_ - 1 ? M_ - 1 : gr);
        float4 s4 = *(const float4*)(g.rss + gr * 4);
        rs[ai][m] = rsqrtf((s4.x + s4.y + s4.z + s4.w) * (1.f / 1024.f) + EPS);
      }
#pragma unroll
    for (int ai = 0; ai < 2; ++ai) for (int bj = 0; bj < 2; ++bj) for (int m = 0; m < 4; ++m) for (int n = 0; n < 2; ++n) {
      int row = ai * 128 + wr * 64 + m * 16 + fr, col = bj * 128 + wc * 32 + n * 16 + fq * 4;
      f32x4 a = acc[ai][bj][m][n]; float s = rs[ai][m];
      h4 v; v[0] = (half_t)(a[0] * s); v[1] = (half_t)(a[1] * s); v[2] = (half_t)(a[2] * s); v[3] = (half_t)(a[3] * s);
      *(h4*)(smem + (row * TS + col) * 2) = v;
    }
    __syncthreads();
    if (EPI == EPI_IN) {
      if (pn <= 1 || (pn >= 4 && pn <= 6)) {
        half_t* tl = (half_t*)smem;
        const int sub = tid & 7;
        const int bb = (int)(brow >> 12), t0 = (int)(brow & (T_ - 1));
        const int nu = (pn <= 1) ? 4 : 2;
        const float* gain = (pn <= 1) ? g.qg : (pn == 5 ? g.kg1 : (pn == 6 ? g.kg2 : nullptr));
        const float scale = (pn <= 1) ? 0.125f * 1.4426950408889634f : 1.f;
        float gn8[8];
#pragma unroll
        for (int i = 0; i < 8; ++i) gn8[i] = gain ? gain[sub * 8 + i] : 1.f;
#pragma unroll 1
        for (int it = 0; it < 4; ++it) {
          const int row = (tid >> 3) + 64 * it; const long m = brow + row;
          float c8[8], s8[8];
#pragma unroll
          for (int i = 0; i < 8; ++i) { c8[i] = 1.f; s8[i] = 0.f; }
          if (sub < 2) {
#pragma unroll
            for (int i = 0; i < 8; ++i) { c8[i] = g.cs[m * 8 + i]; s8[i] = g.sn[m * 8 + i]; }
          }
#pragma unroll 1
          for (int u = 0; u < nu; ++u) {
            half_t* src = tl + row * TS + u * 64 + sub * 8;
            h8 v = *(const h8*)src; float f[8]; float ss = 0.f;
#pragma unroll
            for (int i = 0; i < 8; ++i) { f[i] = (float)v[i]; ss += f[i] * f[i]; }
            ss += __shfl_xor(ss, 1); ss += __shfl_xor(ss, 2); ss += __shfl_xor(ss, 4);
            if (gain) {
              float r = rsqrtf(ss * (1.f / 64.f) + EPS);
#pragma unroll
              for (int i = 0; i < 8; ++i) f[i] = f[i] * r * gn8[i];
            }
            h8 w;
#pragma unroll
            for (int i = 0; i < 8; ++i) {
              float other = __shfl_xor(f[i], 1);
              float o = f[i];
              if (sub == 0) o = f[i] * c8[i] - other * s8[i];
              else if (sub == 1) o = f[i] * c8[i] + other * s8[i];
              w[i] = (half_t)(o * scale);
            }
            *(h8*)src = w;
            if (pn == 4) *(h8*)(g.kcr + ((size_t)(bb * 2 + u) * T_ + t0 + row) * 64 + sub * 8) = w;
          }
        }
        if (pn == 4) {
#pragma unroll
          for (int e = 0; e < 8; ++e) {
            int id = tid + NTH * e; int row = id >> 4, gg = (id >> 3) & 1, c8i = id & 7;
            *(h8*)(g.vcr + ((size_t)(bb * 2 + gg) * T_ + t0 + row) * 64 + c8i * 8) = *(const h8*)(tl + row * TS + 128 + gg * 64 + c8i * 8);
          }
        } else if (pn >= 5) {
          half_t* vdst = (pn == 5) ? g.vst : g.vwt;
          const int d = tid >> 3, kc = tid & 7;
#pragma unroll 1
          for (int q = 0; q < 8; ++q) {
            int kb = q >> 1, gg = q & 1; h8 v;
#pragma unroll
            for (int i = 0; i < 8; ++i) v[i] = tl[(kb * 64 + kc * 8 + i) * TS + 128 + gg * 64 + d];
            *(h8*)(vdst + ((size_t)((bb * 2 + gg) * 64 + (t0 >> 6) + kb)) * 4096 + d * 64 + kc * 8) = v;
          }
        }
        __syncthreads();
      }
      tile_copy_out(smem, g.outh, g.ldo, brow, bcol, tid);
    } else {
      const int cgp = tid & 15;
      const int gc = pn * 128 + cgp * 8;
      float wg[3][8], wu[3][8], bg[8], bu[8];
#pragma unroll
      for (int j = 0; j < 3; ++j)
#pragma unroll
        for (int e = 0; e < 8; ++e) { wg[j][e] = g.convw[j * 5632 + gc + e]; wu[j][e] = g.convw[j * 5632 + 2816 + gc + e]; }
#pragma unroll
      for (int e = 0; e < 8; ++e) { bg[e] = g.convb[gc + e]; bu[e] = g.convb[2816 + gc + e]; }
      if (tid < 128) {
        int sel = tid >> 5, ch = tid & 31; int lr = sel < 2 ? sel : 252 + sel;
        half_t* dst = (sel < 2 ? g.hf : g.hl) + ((size_t)pm * 2 + (sel & 1)) * 5632 + pn * 256 + ch * 8;
        *(h8*)dst = *(const h8*)(smem + (lr * TS + ch * 8) * 2);
      }
      const bool seq_start = ((brow & (T_ - 1)) == 0);
#pragma unroll 1
      for (int e8 = 0; e8 < 8; ++e8) {
        int id = tid + NTH * e8; int lr = id >> 4;
        long gr = brow + lr;
        if (lr >= 2 || seq_start) {
          int t = (int)(gr & (T_ - 1));
          float m1 = t >= 1 ? 1.f : 0.f, m2 = t >= 2 ? 1.f : 0.f;
          const int lr1 = lr >= 1 ? lr - 1 : 0, lr2 = lr >= 2 ? lr - 2 : 0;
          h8 g0 = *(const h8*)(smem + (lr * TS + cgp * 8) * 2), g1 = *(const h8*)(smem + (lr1 * TS + cgp * 8) * 2), g2 = *(const h8*)(smem + (lr2 * TS + cgp * 8) * 2);
          h8 u0 = *(const h8*)(smem + (lr * TS + 128 + cgp * 8) * 2), u1 = *(const h8*)(smem + (lr1 * TS + 128 + cgp * 8) * 2), u2 = *(const h8*)(smem + (lr2 * TS + 128 + cgp * 8) * 2);
          h8 o;
#pragma unroll
          for (int e = 0; e < 8; ++e) {
            float yg = wg[2][e] * (float)g0[e] + m1 * wg[1][e] * (float)g1[e] + m2 * wg[0][e] * (float)g2[e] + bg[e];
            float yu = wu[2][e] * (float)u0[e] + m1 * wu[1][e] * (float)u1[e] + m2 * wu[0][e] * (float)u2[e] + bu[e];
            o[e] = (half_t)(silu_fast(yg) * yu);
          }
          *(h8*)(g.outh + gr * NFF + gc) = o;
        }
      }
    }
  } else if (EPI == EPI_RES) {
    float* S = (float*)smem;
#pragma unroll 1
    for (int ai = 0; ai < 2; ++ai) {
#pragma unroll
      for (int bj = 0; bj < 2; ++bj) for (int m = 0; m < 4; ++m) for (int n = 0; n < 2; ++n) {
        int row = wr * 64 + m * 16 + fr, col = bj * 128 + wc * 32 + n * 16 + fq * 4;
        f32x4 a = ai ? acc[1][bj][m][n] : acc[0][bj][m][n];
        *(f32x4*)(S + row * 260 + col) = a;
      }
      __syncthreads();
      {
        const long grow0 = brow + ai * 128 + wid * 16;
        h4 rv[16];
#pragma unroll
        for (int rr = 0; rr < 16; ++rr) rv[rr] = *(const h4*)(g.outh + (grow0 + rr) * g.ldo + bcol + lane * 4);
#pragma unroll
        for (int rr = 0; rr < 16; ++rr) {
          f32x4 a = *(const f32x4*)(S + (wid * 16 + rr) * 260 + lane * 4);
          float4 xn; xn.x = (float)rv[rr][0] + a[0]; xn.y = (float)rv[rr][1] + a[1]; xn.z = (float)rv[rr][2] + a[2]; xn.w = (float)rv[rr][3] + a[3];
          if (g.xout) {
            *(float4*)(g.xout + (grow0 + rr) * 1024 + bcol + lane * 4) = xn;
          } else {
            float ss = xn.x * xn.x + xn.y * xn.y + xn.z * xn.z + xn.w * xn.w;
#pragma unroll
            for (int o = 32; o >= 1; o >>= 1) ss += __shfl_xor(ss, o);
            if (lane == 0) g.rss_out[(grow0 + rr) * 4 + pn] = ss;
            h4 v; v[0] = (half_t)xn.x; v[1] = (half_t)xn.y; v[2] = (half_t)xn.z; v[3] = (half_t)xn.w;
            *(h4*)(g.outh + (grow0 + rr) * g.ldo + bcol + lane * 4) = v;
          }
        }
      }
      __syncthreads();
    }
  } else {
    if (tid < 256) { float s = 0.f; for (int kc = 0; kc < 16; ++kc) s += g.c1p[kc * 512 + tid]; aux[tid] = s; }
    __syncthreads();
#pragma unroll
    for (int ai = 0; ai < 2; ++ai) for (int bj = 0; bj < 2; ++bj) for (int m = 0; m < 4; ++m) for (int n = 0; n < 2; ++n) {
      int row = ai * 128 + wr * 64 + m * 16 + fr, col = bj * 128 + wc * 32 + n * 16 + fq * 4;
      f32x4 a = acc[ai][bj][m][n]; h4 v;
#pragma unroll
      for (int j = 0; j < 4; ++j) v[j] = (half_t)siluf(a[j] + aux[col + j]);
      *(h4*)(smem + (row * TS + col) * 2) = v;
    }
    __syncthreads();
    {
      const half_t* tl = (const half_t*)smem;
      const int l32 = lane & 31, hf = lane >> 5;
      f32x16 a2[2];
#pragma unroll
      for (int mt = 0; mt < 2; ++mt)
#pragma unroll
        for (int i = 0; i < 16; ++i) a2[mt][i] = 0.f;
#pragma unroll 4
      for (int s = 0; s < 16; ++s) {
        h8 b = *(const h8*)(tl + (32 * wid + l32) * TS + 16 * s + 8 * hf);
        h8 w0 = *(const h8*)(g.w2t + (l32) * 256 + 16 * s + 8 * hf);
        h8 w1 = *(const h8*)(g.w2t + (32 + l32) * 256 + 16 * s + 8 * hf);
        a2[0] = mfma32(w0, b, a2[0]); a2[1] = mfma32(w1, b, a2[1]);
      }
      const int ci = 32 * wid + l32; const int bgi = pm;
      if (g.kv == 0) {
        float ss = 0.f;
#pragma unroll
        for (int mt = 0; mt < 2; ++mt)
#pragma unroll
          for (int i = 0; i < 16; ++i) ss += a2[mt][i] * a2[mt][i];
        ss += __shfl_xor(ss, 32);
        float rr = rsqrtf(ss * (1.f / 64.f) + EPS);
#pragma unroll
        for (int mt = 0; mt < 2; ++mt)
#pragma unroll
          for (int r = 0; r < 4; ++r) {
            int d0 = 32 * mt + 8 * r + 4 * hf; h4 v;
#pragma unroll
            for (int i = 0; i < 4; ++i) v[i] = (half_t)(a2[mt][4 * r + i] * rr * g.kg0[d0 + i]);
            *(h4*)(g.kc + ((size_t)bgi * 256 + ci) * 64 + d0) = v;
          }
      } else {
#pragma unroll
        for (int mt = 0; mt < 2; ++mt)
#pragma unroll
          for (int rg = 0; rg < 16; ++rg) {
            int d = 32 * mt + crow(rg, hf);
            g.vct[((size_t)(bgi * 4 + (ci >> 6)) * 64 + d) * 64 + (ci & 63)] = (half_t)a2[mt][rg];
          }
      }
    }
  }
  __syncthreads();
}

DI void tile_decode(int t, int nM, int nN, int& pm, int& pn) {
  int per = 16 * nN; int sr = t / per; int rem = t - sr * per;
  int width = nM - sr * 16; if (width > 16) width = 16;
  pn = rem / width; pm = sr * 16 + rem % width;
}

template <int EPI>
__device__ void gemm_phase(const GArgs& g, char* smem) {
  int nt = g.nM * g.nN;
  for (int t = blockIdx.x; t < nt; t += gridDim.x) { int pm, pn; tile_decode(t, g.nM, g.nN, pm, pn); gemm_tile<EPI>(g, pm, pn, smem); }
}

__device__ void phase_prep(const Params& p, int l, char* smem) {
  char* ws = p.ws;
  half_t* proj = (half_t*)(ws + WS_PROJ);
  half_t* kcr = (half_t*)(ws + WS_KCR); half_t* vcr = (half_t*)(ws + WS_VCR);
  half_t* vst = (half_t*)(ws + WS_VST); half_t* vwt = (half_t*)(ws + WS_VWT);
  const float* cs = (const float*)(ws + WS_COS); const float* sn = (const float*)(ws + WS_SIN);
  const int tid = ltid();
  half_t* tl = (half_t*)smem;
  for (int it = blockIdx.x; it < 512; it += gridDim.x) {
    int b = it >> 6, blk = it & 63; long m0 = (long)b * T_ + blk * 64;
    {
      int tok = tid >> 3, sub = tid & 7; long m = m0 + tok; int t = blk * 64 + tok;
      float c8[8], s8[8];
      if (sub < 2) {
#pragma unroll
        for (int i = 0; i < 8; ++i) { c8[i] = cs[m * 8 + i]; s8[i] = sn[m * 8 + i]; }
      }
      h8 uv[14];
#pragma unroll
      for (int u = 0; u < 14; ++u) {
        int col = (u < 8) ? u * 64 : (u < 10 ? 1024 + (u - 8) * 64 : (u < 12 ? 1024 + 256 + (u - 10) * 64 : 1024 + 512 + (u - 12) * 64));
        uv[u] = *(const h8*)(proj + m * PL + col + sub * 8);
      }
      float gq[8], gs[8], gw[8];
#pragma unroll
      for (int i = 0; i < 8; ++i) { gq[i] = p.q_norm[l * 64 + sub * 8 + i]; gs[i] = p.k_norm[(l * 3 + 1) * 64 + sub * 8 + i]; gw[i] = p.k_norm[(l * 3 + 2) * 64 + sub * 8 + i]; }
#pragma unroll
      for (int u = 0; u < 14; ++u) {
        int col = (u < 8) ? u * 64 : (u < 10 ? 1024 + (u - 8) * 64 : (u < 12 ? 1024 + 256 + (u - 10) * 64 : 1024 + 512 + (u - 12) * 64));
        const bool norm = !(u == 8 || u == 9);
        const float scale = (u < 8) ? 0.125f * 1.4426950408889634f : 1.f;
        h8 v = uv[u]; float f[8]; float ss = 0.f;
#pragma unroll
        for (int i = 0; i < 8; ++i) { f[i] = (float)v[i]; ss += f[i] * f[i]; }
        if (norm) {
          ss += __shfl_xor(ss, 1); ss += __shfl_xor(ss, 2); ss += __shfl_xor(ss, 4);
          float r = rsqrtf(ss * (1.f / 64.f) + EPS);
#pragma unroll
          for (int i = 0; i < 8; ++i) f[i] = f[i] * r * (u < 8 ? gq[i] : (u < 12 ? gs[i] : gw[i]));
        }
        float o[8];
#pragma unroll
        for (int i = 0; i < 8; ++i) {
          float other = __shfl_xor(f[i], 1);
          o[i] = f[i];
          if (sub == 0) o[i] = f[i] * c8[i] - other * s8[i];
          else if (sub == 1) o[i] = f[i] * c8[i] + other * s8[i];
          o[i] *= scale;
        }
        h8 w;
#pragma unroll
        for (int i = 0; i < 8; ++i) w[i] = (half_t)o[i];
        if (u == 8 || u == 9) { int g = u - 8; *(h8*)(kcr + ((size_t)(b * 2 + g) * T_ + t) * 64 + sub * 8) = w; }
        else *(h8*)(proj + m * PL + col + sub * 8) = w;
      }
    }
#pragma unroll
    for (int e = 0; e < 2; ++e) {
      int id = tid + NTH * e; int tok = id >> 4, g = (id >> 3) & 1, c8i = id & 7;
      h8 v = *(const h8*)(proj + (m0 + tok) * PL + 1024 + 128 + g * 64 + c8i * 8);
      *(h8*)(vcr + ((size_t)(b * 2 + g) * T_ + blk * 64 + tok) * 64 + c8i * 8) = v;
    }
#pragma unroll 1
    for (int q = 0; q < 4; ++q) {
      int g = q & 1; int col = 1024 + (q < 2 ? 256 : 512) + 128 + g * 64;
      half_t* dst = (q < 2 ? vst : vwt) + ((size_t)((b * 2 + g) * 64 + blk)) * 4096;
      __syncthreads();
      { int tok = tid >> 3, c8i = tid & 7; h8 v = *(const h8*)(proj + (m0 + tok) * PL + col + c8i * 8);
#pragma unroll
        for (int i = 0; i < 8; ++i) tl[tok * 66 + c8i * 8 + i] = v[i]; }
      __syncthreads();
      { int d = tid >> 3, kc = tid & 7; h8 v;
#pragma unroll
        for (int i = 0; i < 8; ++i) v[i] = tl[(kc * 8 + i) * 66 + d];
        *(h8*)(dst + d * 64 + kc * 8) = v; }
    }
    __syncthreads();
  }
}

__device__ void gdn_pre_item(const Params& p, int l, int item, char* smem) {
  char* ws = p.ws;
  const half_t* proj = (const half_t*)(ws + WS_PROJ);
  half_t* WG = (half_t*)p.out; half_t* QG = WG + (size_t)M_ * 512; half_t* UG = QG + (size_t)M_ * 512;
  half_t* KTG = UG + (size_t)M_ * 512; half_t* AQK = (half_t*)(ws + WS_AQK); float* GL = (float*)(ws + WS_GL);
  int tid_ = threadIdx.x; asm volatile("" : "+v"(tid_));
  const int tid = tid_, wid = tid >> 6, lane = tid & 63;
  const int bh = item >> 6, n = item & 63, b = bh >> 2, h = bh & 3;
  const int cid = item; const long m0 = (long)b * T_ + n * 64;
  constexpr int RS = 392;
  half_t* raw = (half_t*)smem;
  float* Akk = (float*)smem; half_t* Th = (half_t*)(smem + 16384); half_t* KtT = (half_t*)(smem + 25600);
  float* TL = (float*)(smem + 44032);
  half_t* Kn = (half_t*)(smem + 61440);
  half_t* Qn = (half_t*)(smem + 78848);
  half_t* Vn = (half_t*)(smem + 96256);
  half_t* VbT = (half_t*)(smem + 113664);
  half_t* KbgT = (half_t*)(smem + 132096);
  float* gv = (float*)(smem + 150528);
  float* gcum = gv; float* beta = gv + 64;

  for (int id = tid; id < 67 * 48; id += NTH) {
    int rr = id / 48, ch = id % 48; int arr = ch >> 4, c8i = ch & 15;
    int t = n * 64 - 3 + rr;
    h8 v = {0, 0, 0, 0, 0, 0, 0, 0};
    if (t >= 0) v = *(const h8*)(proj + ((long)b * T_ + t) * PL + 1792 + arr * 512 + h * 128 + c8i * 8);
    *(h8*)(raw + rr * RS + arr * 128 + c8i * 8) = v;
  }
  if (wid == 0) {
    float a = (float)proj[(m0 + lane) * PL + 3352 + h], bb = (float)proj[(m0 + lane) * PL + 3356 + h];
    float xx = a + p.gdn_dt_bias[l * 4 + h];
    float ey = __expf(-fabsf(xx));
    float l1p = ey < 0.01f ? ey * (1.f - ey * (0.5f - ey * (1.f / 3.f))) : __logf(1.f + ey);
    float sp = fmaxf(xx, 0.f) + l1p;
    float gval = -expf(p.gdn_a_log[l * 4 + h]) * sp;
#pragma unroll
    for (int o = 1; o < 64; o <<= 1) { float y = __shfl_up(gval, o); if (lane >= o) gval += y; }
    gcum[lane] = gval; beta[lane] = sigm(bb);
  }
  __syncthreads();
  const int r = tid >> 3, sub = tid & 7;
  {
    const float* cw = p.gdn_conv_w + (size_t)l * 4 * 1536;
#pragma unroll 1
    for (int arr = 0; arr < 3; ++arr) {
      float y[16]; float ss = 0.f;
#pragma unroll
      for (int e2 = 0; e2 < 16; ++e2) y[e2] = 0.f;
#pragma unroll
      for (int j = 0; j < 4; ++j) {
        const half_t* xr = raw + (r + j) * RS + arr * 128 + sub * 16;
        h8 x0 = *(const h8*)xr, x1 = *(const h8*)(xr + 8);
        const float* wp = cw + j * 1536 + arr * 512 + h * 128 + sub * 16;
        float4 w0 = *(const float4*)wp, w1 = *(const float4*)(wp + 4), w2 = *(const float4*)(wp + 8), w3 = *(const float4*)(wp + 12);
        y[0] += w0.x * (float)x0[0]; y[1] += w0.y * (float)x0[1]; y[2] += w0.z * (float)x0[2]; y[3] += w0.w * (float)x0[3];
        y[4] += w1.x * (float)x0[4]; y[5] += w1.y * (float)x0[5]; y[6] += w1.z * (float)x0[6]; y[7] += w1.w * (float)x0[7];
        y[8] += w2.x * (float)x1[0]; y[9] += w2.y * (float)x1[1]; y[10] += w2.z * (float)x1[2]; y[11] += w2.w * (float)x1[3];
        y[12] += w3.x * (float)x1[4]; y[13] += w3.y * (float)x1[5]; y[14] += w3.z * (float)x1[6]; y[15] += w3.w * (float)x1[7];
      }
#pragma unroll
      for (int e2 = 0; e2 < 16; ++e2) { float a = silu_fast(y[e2]); y[e2] = a; ss += a * a; }
      ss += __shfl_xor(ss, 1); ss += __shfl_xor(ss, 2); ss += __shfl_xor(ss, 4);
      float sc = (arr == 0) ? rsqrtf(ss + EPS) * 0.08838834764831845f : (arr == 1 ? rsqrtf(ss + EPS) : 1.f);
      half_t* dst = (arr == 0) ? Qn : (arr == 1 ? Kn : Vn);
      h8 o0, o1;
#pragma unroll
      for (int e2 = 0; e2 < 8; ++e2) { o0[e2] = (half_t)(y[e2] * sc); o1[e2] = (half_t)(y[8 + e2] * sc); }
      *(h8*)(dst + r * 136 + sub * 16) = o0; *(h8*)(dst + r * 136 + sub * 16 + 8) = o1;
    }
  }
  __syncthreads();
  {
    float gc = gcum[r], bt = beta[r], gl = gcum[63];
    float eg = expf(gc), ek = expf(gl - gc);
    h8 q0, q1;
    h8 kv8[2], vv8[2], qv8[2];
    kv8[0] = *(const h8*)(Kn + r * 136 + sub * 16); kv8[1] = *(const h8*)(Kn + r * 136 + sub * 16 + 8);
    vv8[0] = *(const h8*)(Vn + r * 136 + sub * 16); vv8[1] = *(const h8*)(Vn + r * 136 + sub * 16 + 8);
    qv8[0] = *(const h8*)(Qn + r * 136 + sub * 16); qv8[1] = *(const h8*)(Qn + r * 136 + sub * 16 + 8);
#pragma unroll
    for (int e = 0; e < 16; ++e) {
      int d = sub * 16 + e;
      float kk = (float)kv8[e >> 3][e & 7], vv = (float)vv8[e >> 3][e & 7], qq = (float)qv8[e >> 3][e & 7];
      KbgT[d * 72 + r] = (half_t)(kk * bt * eg);
      VbT[d * 72 + r] = (half_t)(vv * bt);
      KtT[d * 72 + r] = (half_t)(kk * ek);
      half_t qv = (half_t)(qq * eg);
      if (e < 8) q0[e] = qv; else q1[e - 8] = qv;
    }
    *(h8*)(QG + (m0 + r) * 512 + h * 128 + sub * 16) = q0;
    *(h8*)(QG + (m0 + r) * 512 + h * 128 + sub * 16 + 8) = q1;
    if (tid == 0) GL[cid] = expf(gl);
  }
  __syncthreads();
  {
    const int which = wid >> 2, ti = (wid >> 1) & 1, tj = wid & 1, l32 = lane & 31, hf = lane >> 5;
    const half_t* Am = which ? Qn : Kn;
    f32x16 acc;
#pragma unroll
    for (int i = 0; i < 16; ++i) acc[i] = 0.f;
#pragma unroll
    for (int s = 0; s < 8; ++s) {
      h8 a = *(const h8*)(Am + (32 * ti + l32) * 136 + 16 * s + 8 * hf);
      h8 bb = *(const h8*)(Kn + (32 * tj + l32) * 136 + 16 * s + 8 * hf);
      acc = mfma32(a, bb, acc);
    }
    int j = 32 * tj + l32; float gj = gcum[j];
#pragma unroll
    for (int rg = 0; rg < 16; ++rg) {
      int i = 32 * ti + crow(rg, hf); float gi = gcum[i];
      if (which == 0) { float v = (j < i) ? beta[i] * acc[rg] * expf(gi - gj) : 0.f; Akk[i * 64 + j] = v; }
      else { float v = (j <= i) ? acc[rg] * expf(gi - gj) : 0.f; AQK[(size_t)cid * 4096 + i * 64 + j] = (half_t)v; }
    }
#pragma unroll
    for (int e = 0; e < 2; ++e) { int id = tid + NTH * e; int row = id >> 3, c8i = id & 7;
      *(h8*)(KTG + (size_t)cid * 8192 + row * 64 + c8i * 8) = *(const h8*)(KtT + row * 72 + c8i * 8); }
  }
  __syncthreads();
  float* Dg = TL + 64 * 65;
  float* RB = Dg + 1024;
  if (wid == 0) {
    const int blk = lane >> 4, cc = lane & 15;
    float x[16];
#pragma unroll
    for (int ii = 0; ii < 16; ++ii) {
      const float* ar = Akk + (16 * blk + ii) * 64 + 16 * blk;
      f32x4 a0 = *(const f32x4*)ar, a1 = *(const f32x4*)(ar + 4), a2 = *(const f32x4*)(ar + 8), a3 = *(const f32x4*)(ar + 12);
      float av[16] = {a0[0], a0[1], a0[2], a0[3], a1[0], a1[1], a1[2], a1[3], a2[0], a2[1], a2[2], a2[3], a3[0], a3[1], a3[2], a3[3]};
      float a = (ii == cc) ? 1.f : 0.f;
#pragma unroll
      for (int jj = 0; jj < ii; ++jj) a -= av[jj] * x[jj];
      x[ii] = a;
    }
#pragma unroll
    for (int ii = 0; ii < 16; ++ii) Dg[(blk * 16 + ii) * 16 + cc] = x[ii];
  }
  __syncthreads();
#pragma unroll 1
  for (int I = 0; I < 4; ++I) {
    const int il = tid >> 5, c0 = (tid & 31) * 2; const int i = 16 * I + il;
    {
      float a0 = (i == c0) ? 1.f : 0.f, a1 = (i == c0 + 1) ? 1.f : 0.f;
      for (int j = 0; j < 16 * I; ++j) { float av = Akk[i * 64 + j]; a0 -= av * TL[j * 65 + c0]; a1 -= av * TL[j * 65 + c0 + 1]; }
      RB[il * 65 + c0] = a0; RB[il * 65 + c0 + 1] = a1;
    }
    __syncthreads();
    {
      float t0 = 0.f, t1 = 0.f;
#pragma unroll
      for (int k = 0; k < 16; ++k) { float dv = Dg[(I * 16 + il) * 16 + k]; t0 += dv * RB[k * 65 + c0]; t1 += dv * RB[k * 65 + c0 + 1]; }
      TL[i * 65 + c0] = t0; TL[i * 65 + c0 + 1] = t1;
      Th[i * 72 + c0] = (half_t)t0; Th[i * 72 + c0 + 1] = (half_t)t1;
    }
    __syncthreads();
  }
  {
    const int ti = wid >> 2, tj = wid & 3, l32 = lane & 31, hf = lane >> 5;
    f32x16 au, aw;
#pragma unroll
    for (int i = 0; i < 16; ++i) { au[i] = 0.f; aw[i] = 0.f; }
#pragma unroll
    for (int s = 0; s < 4; ++s) {
      h8 a = *(const h8*)(Th + (32 * ti + l32) * 72 + 16 * s + 8 * hf);
      h8 bu = *(const h8*)(VbT + (32 * tj + l32) * 72 + 16 * s + 8 * hf);
      h8 bw = *(const h8*)(KbgT + (32 * tj + l32) * 72 + 16 * s + 8 * hf);
      au = mfma32(a, bu, au); aw = mfma32(a, bw, aw);
    }
#pragma unroll
    for (int rg = 0; rg < 16; ++rg) {
      int i = 32 * ti + crow(rg, hf); int dv = 32 * tj + l32;
      UG[(m0 + i) * 512 + h * 128 + dv] = (half_t)au[rg];
      WG[(m0 + i) * 512 + h * 128 + dv] = (half_t)aw[rg];
    }
  }
  __syncthreads();
}

__device__ void phase_cmp2(const Params& p, int l, char* smem) {
  char* ws = p.ws;
  const half_t* hid = (const half_t*)(ws + WS_HID);
  half_t* KC = (half_t*)(ws + WS_KC); half_t* VCT = (half_t*)(ws + WS_VCT);
  const int tid = ltid();
  half_t* hl = (half_t*)smem;
  float* w2 = (float*)(smem + 64 * 264 * 2);
  for (int it = blockIdx.x; it < 128; it += gridDim.x) {
    int kv = it >> 6, bg = (it >> 2) & 15, Tt = it & 3;
    const half_t* src = hid + ((size_t)kv * 4096 + bg * 256 + Tt * 64) * 256;
#pragma unroll
    for (int e = 0; e < 4; ++e) { int id = tid + NTH * e; int row = id >> 5, c16 = id & 31; *(h8*)(hl + row * 264 + c16 * 8) = *(const h8*)(src + row * 256 + c16 * 8); }
    const float* w2g = p.cmp_w2 + (size_t)(l * 2 + kv) * 256 * 64;
#pragma unroll
    for (int e = 0; e < 8; ++e) { int id = tid + NTH * e; *(float4*)(w2 + id * 4) = *(const float4*)(w2g + id * 4); }
    __syncthreads();
    int r = tid >> 3, dg = tid & 7; float acc[8];
#pragma unroll
    for (int i = 0; i < 8; ++i) acc[i] = 0.f;
    for (int k = 0; k < 256; ++k) {
      float hv = (float)hl[r * 264 + k];
      float4 wa = *(const float4*)(w2 + k * 64 + dg * 8), wb = *(const float4*)(w2 + k * 64 + dg * 8 + 4);
      acc[0] += hv * wa.x; acc[1] += hv * wa.y; acc[2] += hv * wa.z; acc[3] += hv * wa.w;
      acc[4] += hv * wb.x; acc[5] += hv * wb.y; acc[6] += hv * wb.z; acc[7] += hv * wb.w;
    }
    if (kv == 0) {
      float ss = 0.f;
#pragma unroll
      for (int i = 0; i < 8; ++i) ss += acc[i] * acc[i];
      ss += __shfl_xor(ss, 1); ss += __shfl_xor(ss, 2); ss += __shfl_xor(ss, 4);
      float rr = rsqrtf(ss * (1.f / 64.f) + EPS);
      h8 v;
#pragma unroll
      for (int i = 0; i < 8; ++i) v[i] = (half_t)(acc[i] * rr * p.k_norm[(l * 3 + 0) * 64 + dg * 8 + i]);
      *(h8*)(KC + ((size_t)bg * 256 + Tt * 64 + r) * 64 + dg * 8) = v;
    } else {
#pragma unroll
      for (int i = 0; i < 8; ++i) VCT[((size_t)(bg * 4 + Tt) * 64 + dg * 8 + i) * 64 + r] = (half_t)acc[i];
    }
    __syncthreads();
  }
}

constexpr int KVS = 72;
struct NsaCtx {
  const half_t* proj; const half_t* KC; const half_t* VCT; const half_t* VST; const half_t* VWT;
  int b, g, qb, bg; int tq; int l32, hf; int tid;
};

template <int MODE>
DI void nsa_branch(const NsaCtx& c, char* smem, int& bufsel, const h8 (&qf)[4], const float shift, float& l_run, f32x16 (&ot)[2],
                   float (&imp)[32], const unsigned* selmask_q, const unsigned* unionmask) {
  const int tid = c.tid;
  const int l32 = c.l32, hf = c.hf;
  const int ql = c.tq & 63;
  int cilim = (c.tq - 31) >> 4; if (cilim > 254) cilim = 254;
  unsigned um0 = 0, um1 = 0, sm0 = 0, sm1 = 0;
  if (MODE == 2) { um0 = unionmask[0]; um1 = unionmask[1]; sm0 = selmask_q[0]; sm1 = selmask_q[1]; }
  int jlo, jhi;
  if (MODE <= 1) { int cnt = 4 * c.qb + 3; if (cnt > 255) cnt = 255; jlo = 0; jhi = (cnt + 63) / 64 - 1; }
  else if (MODE == 2) { jlo = 0; jhi = c.qb; }
  else { jlo = c.qb - 8 < 0 ? 0 : c.qb - 8; jhi = c.qb; }
  auto next_tile = [&](int j) -> int {
    ++j;
    if (MODE == 2) { while (j <= jhi && !(((j < 32 ? um0 >> j : um1 >> (j - 32)) & 1u))) ++j; }
    return j <= jhi ? j : -1;
  };
  h8 kreg[2], vreg[2];
  auto load_regs = [&](int j, h8& kr, h8& vr) {
    int row = tid >> 3, c8i = tid & 7;
    if (MODE <= 1) {
      kr = *(const h8*)(c.KC + ((size_t)c.bg * 256 + j * 64 + row) * 64 + c8i * 8);
      if (MODE == 1) vr = *(const h8*)(c.VCT + (size_t)(c.bg * 4 + j) * 4096 + tid * 8);
    } else {
      int col = 1024 + (MODE == 2 ? 256 : 512) + c.g * 64;
      kr = *(const h8*)(c.proj + ((size_t)c.b * T_ + j * 64 + row) * PL + col + c8i * 8);
      vr = *(const h8*)((MODE == 2 ? c.VST : c.VWT) + (size_t)(c.bg * 64 + j) * 4096 + tid * 8);
    }
  };
  float ylast = 0.f;
  auto compute = [&](int j, const half_t* K, const half_t* V) {
    bool selj = true;
    if (MODE == 2) selj = ((j < 32 ? sm0 >> j : sm1 >> (j - 32)) & 1u) != 0;
    const float init = selj ? -shift : -INFINITY;
    bool need_mask; int lim = 63, lo = 0;
    if (MODE <= 1) { need_mask = true; lim = cilim - 64 * j; }
    else if (MODE == 2) { need_mask = (j == c.qb); lim = ql; }
    else { need_mask = (j == c.qb) || (j == c.qb - 8); if (j == c.qb) lim = ql; else lo = ql + 1; }
    float ps = 0.f;
#pragma unroll
    for (int kt = 0; kt < 2; ++kt) {
      f32x16 st;
      {
        h8 kf[4];
#pragma unroll
        for (int s = 0; s < 4; ++s) kf[s] = *(const h8*)(K + (32 * kt + l32) * KVS + 16 * s + 8 * hf);
#pragma unroll
        for (int i = 0; i < 16; ++i) st[i] = init;
#pragma unroll
        for (int s = 0; s < 4; ++s) st = mfma32(kf[s], qf[s], st);
        __builtin_amdgcn_sched_group_barrier(0x100, 4, 0);
        __builtin_amdgcn_sched_group_barrier(0x008, 4, 0);
      }
      if (need_mask) {
        asm volatile("; boundary tile mask" ::: );
#pragma unroll
        for (int rg = 0; rg < 16; ++rg) {
          int key = 32 * kt + crow(rg, hf);
          st[rg] = (key <= lim && key >= lo) ? st[rg] : -INFINITY;
        }
      }
#pragma unroll
      for (int rg = 0; rg < 16; ++rg) { float pv = EXP2(st[rg]); st[rg] = pv; ps += pv; }
      if (MODE == 1) {
        float y[4];
#pragma unroll
        for (int r = 0; r < 4; ++r) y[r] = __shfl_xor(st[4 * r + 3], 32);
#pragma unroll
        for (int r = 0; r < 4; ++r) {
          float own = st[4 * r] + st[4 * r + 1] + st[4 * r + 2] + st[4 * r + 3];
          float prev = (r > 0) ? y[r - 1] : ylast;
          float carry = hf ? y[r] : prev;
          float add = own + carry;
#pragma unroll
          for (int Tt = 0; Tt < 4; ++Tt) imp[Tt * 8 + kt * 4 + r] += (j == Tt) ? add : 0.f;
        }
        ylast = y[3];
      }
      h8 pf[2];
#pragma unroll
      for (int s2 = 0; s2 < 2; ++s2)
#pragma unroll
        for (int i2 = 0; i2 < 4; ++i2) {
          h2 pr = __builtin_bit_cast(h2, __builtin_amdgcn_cvt_pkrtz(st[8 * s2 + 2 * i2], st[8 * s2 + 2 * i2 + 1]));
          pf[s2][2 * i2] = pr[0]; pf[s2][2 * i2 + 1] = pr[1];
        }
      {
        h8 vf[2][2];
#pragma unroll
        for (int dt = 0; dt < 2; ++dt)
#pragma unroll
          for (int s2 = 0; s2 < 2; ++s2) {
            h4 v0 = *(const h4*)(V + (32 * dt + l32) * KVS + 32 * kt + 16 * s2 + 4 * hf);
            h4 v1 = *(const h4*)(V + (32 * dt + l32) * KVS + 32 * kt + 16 * s2 + 8 + 4 * hf);
            vf[dt][s2] = cat44(v0, v1);
          }
#pragma unroll
        for (int s2 = 0; s2 < 2; ++s2)
#pragma unroll
          for (int dt = 0; dt < 2; ++dt) ot[dt] = mfma32(vf[dt][s2], pf[s2], ot[dt]);
      }
    }
    l_run += ps;
  };
  int ja = next_tile(jlo - 1);
  int jb = ja >= 0 ? next_tile(ja) : -1;
  if (ja >= 0) load_regs(ja, kreg[0], vreg[0]);
  if (jb >= 0) load_regs(jb, kreg[1], vreg[1]);
  while (ja >= 0) {
    char* sb = smem + bufsel * 36864;
    { int row = tid >> 3, c8i = tid & 7;
      *(h8*)((half_t*)(sb) + row * KVS + c8i * 8) = kreg[0];
      if (MODE != 0) *(h8*)((half_t*)(sb + 18432) + row * KVS + c8i * 8) = vreg[0];
      if (jb >= 0) {
        *(h8*)((half_t*)(sb + 9216) + row * KVS + c8i * 8) = kreg[1];
        if (MODE != 0) *(h8*)((half_t*)(sb + 27648) + row * KVS + c8i * 8) = vreg[1];
      } }
    __syncthreads();
    int jc = jb >= 0 ? next_tile(jb) : -1;
    int jd = jc >= 0 ? next_tile(jc) : -1;
    if (jc >= 0) load_regs(jc, kreg[0], vreg[0]);
    if (jd >= 0) load_regs(jd, kreg[1], vreg[1]);
    compute(ja, (const half_t*)sb, (const half_t*)(sb + 18432));
    if (jb >= 0) compute(jb, (const half_t*)(sb + 9216), (const half_t*)(sb + 27648));
    bufsel ^= 1; ja = jc; jb = jd;
  }
}

__device__ void nsa_item(const Params& p, int l, int item, char* smem, int dry = 0) {
  char* ws = p.ws;
  half_t* proj = (half_t*)(ws + WS_PROJ);
  int tid_ = threadIdx.x; asm volatile("" : "+v"(tid_));
  const int tid = tid_, wid = tid >> 6, lane = tid & 63;
  NsaCtx c; c.tid = tid;
  c.proj = proj; c.KC = (const half_t*)(ws + WS_KC); c.VCT = (const half_t*)(ws + WS_VCT);
  c.VST = (const half_t*)(ws + WS_VST); c.VWT = (const half_t*)(ws + WS_VWT);
  c.qb = 63 - (item >> 4); c.bg = item & 15; c.b = c.bg >> 1; c.g = c.bg & 1;
  c.l32 = lane & 31; c.hf = lane >> 5;
  const int hp = wid >> 1, qhalf = wid & 1, h = c.g * 4 + hp;
  const int ql = 32 * qhalf + c.l32;
  c.tq = c.qb * 64 + ql;
  const long mq = (long)c.b * T_ + c.tq;
  float* impbuf = (float*)(smem + 73728);
  float* seltot = (float*)(smem + 73728 + 65536);
  unsigned* selmask = (unsigned*)(smem + 73728 + 65536 + 16384);
  unsigned* unionmask = selmask + 128;
  h8 qf[4];
#pragma unroll
  for (int s = 0; s < 4; ++s) qf[s] = *(const h8*)(proj + mq * PL + h * 64 + 16 * s + 8 * c.hf);
  float gate[3];
#pragma unroll
  for (int br = 0; br < 3; ++br) gate[br] = sigm((float)proj[mq * PL + 3328 + h * 3 + br]);
  f32x16 outacc[2], ot[2];
#pragma unroll
  for (int dt = 0; dt < 2; ++dt)
#pragma unroll
    for (int i = 0; i < 16; ++i) { outacc[dt][i] = 0.f; ot[dt][i] = 0.f; }
  float imp[32];
#pragma unroll
  for (int i = 0; i < 32; ++i) imp[i] = 0.f;
  int bufsel = 0;
  if (tid < 130) selmask[tid] = 0u;
  float shiftv[3];
  {
    float gq = fabsf(p.q_norm[l * 64 + lane]);
    float g0 = fabsf(p.k_norm[(l * 3 + 0) * 64 + lane]), g1 = fabsf(p.k_norm[(l * 3 + 1) * 64 + lane]), g2 = fabsf(p.k_norm[(l * 3 + 2) * 64 + lane]);
#pragma unroll
    for (int o = 32; o >= 1; o >>= 1) { gq = fmaxf(gq, __shfl_xor(gq, o)); g0 = fmaxf(g0, __shfl_xor(g0, o)); g1 = fmaxf(g1, __shfl_xor(g1, o)); g2 = fmaxf(g2, __shfl_xor(g2, o)); }
    shiftv[0] = fmaxf(0.f, 11.5416f * gq * g0 - 14.f); shiftv[1] = fmaxf(0.f, 11.5416f * gq * g1 - 14.f); shiftv[2] = fmaxf(0.f, 11.5416f * gq * g2 - 14.f);
  }
  float l_run = 0.f;
  nsa_branch<1>(c, smem, bufsel, qf, shiftv[0], l_run, ot, imp, nullptr, nullptr);
  { float lt = l_run + __shfl_xor(l_run, 32); float inv = lt > 0.f ? 1.f / lt : 0.f;
#pragma unroll
    for (int dt = 0; dt < 2; ++dt)
#pragma unroll
      for (int i = 0; i < 16; ++i) { outacc[dt][i] += gate[0] * inv * ot[dt][i]; ot[dt][i] = 0.f; }
#pragma unroll
    for (int i = 0; i < 32; ++i) {
      int Tt = i >> 3, kt = (i >> 2) & 1, r = i & 3;
      impbuf[(hp * 64 + ql) * 64 + 16 * Tt + 8 * kt + 2 * r + c.hf] = imp[i] * inv;
    } }
  __syncthreads();
  {
    int q = tid >> 3, sub = tid & 7; int cur = c.qb;
#pragma unroll
    for (int k = 0; k < 8; ++k) {
      int j = sub + 8 * k;
      float v = impbuf[(0 * 64 + q) * 64 + j] + impbuf[(1 * 64 + q) * 64 + j] + impbuf[(2 * 64 + q) * 64 + j] + impbuf[(3 * 64 + q) * 64 + j];
      if (j == 0 || j == cur || j == cur - 1) v = INFINITY;
      else if (j > cur) v = -INFINITY;
      seltot[q * 64 + j] = v;
    }
  }
  __syncthreads();
  {
    int q = tid >> 3, sub = tid & 7;
    float mine[8]; int rank[8];
#pragma unroll
    for (int k = 0; k < 8; ++k) { mine[k] = seltot[q * 64 + sub + 8 * k]; rank[k] = 0; }
    for (int jj = 0; jj < 64; ++jj) {
      float o = seltot[q * 64 + jj];
#pragma unroll
      for (int k = 0; k < 8; ++k) { int j = sub + 8 * k; rank[k] += (o > mine[k] || (o == mine[k] && jj < j)) ? 1 : 0; }
    }
    unsigned b0 = 0, b1 = 0;
#pragma unroll
    for (int k = 0; k < 8; ++k) { int j = sub + 8 * k; if (rank[k] < 16) { if (j < 32) b0 |= 1u << j; else b1 |= 1u << (j - 32); } }
    if (b0) { atomicOr(&selmask[q * 2], b0); atomicOr(&unionmask[0], b0); }
    if (b1) { atomicOr(&selmask[q * 2 + 1], b1); atomicOr(&unionmask[1], b1); }
  }
  __syncthreads();
  l_run = 0.f;
  nsa_branch<2>(c, smem, bufsel, qf, shiftv[1], l_run, ot, imp, selmask + ql * 2, unionmask);
  { float lt = l_run + __shfl_xor(l_run, 32); float inv = lt > 0.f ? 1.f / lt : 0.f;
#pragma unroll
    for (int dt = 0; dt < 2; ++dt)
#pragma unroll
      for (int i = 0; i < 16; ++i) { outacc[dt][i] += gate[1] * inv * ot[dt][i]; ot[dt][i] = 0.f; } }
  l_run = 0.f;
  nsa_branch<3>(c, smem, bufsel, qf, shiftv[2], l_run, ot, imp, nullptr, nullptr);
  { float lt = l_run + __shfl_xor(l_run, 32); float inv = lt > 0.f ? 1.f / lt : 0.f;
#pragma unroll
    for (int dt = 0; dt < 2; ++dt)
#pragma unroll
      for (int i = 0; i < 16; ++i) outacc[dt][i] += gate[2] * inv * ot[dt][i]; }
  float ss = 0.f;
#pragma unroll
  for (int dt = 0; dt < 2; ++dt)
#pragma unroll
    for (int i = 0; i < 16; ++i) ss += outacc[dt][i] * outacc[dt][i];
  ss += __shfl_xor(ss, 32);
  float rr = rsqrtf(ss * (1.f / 64.f) + EPS);
  int t2 = tid; asm volatile("" : "+v"(t2));
  const int h2 = c.g * 4 + (t2 >> 7);
  const long mq2 = (long)c.b * T_ + c.qb * 64 + 32 * ((t2 >> 6) & 1) + (t2 & 31);
  const float* og = p.nsa_out_norm + (size_t)(l * 8 + h2) * 64;
#pragma unroll
  for (int dt = 0; dt < 2; ++dt)
#pragma unroll
    for (int r = 0; r < 4; ++r) {
      int d0 = 32 * dt + 8 * r + 4 * c.hf; h4 v;
#pragma unroll
      for (int i = 0; i < 4; ++i) v[i] = (half_t)(outacc[dt][4 * r + i] * rr * og[d0 + i]);
      *(h4*)(proj + mq2 * PL + (dry ? 2304 : 0) + h2 * 64 + d0) = v;
    }
  __syncthreads();
}

__device__ void gdn_scan_item(const Params& p, int l, int bh, char* smem, int dry = 0) {
  char* ws = p.ws;
  half_t* proj = (half_t*)(ws + WS_PROJ);
  const half_t* WG = (const half_t*)p.out; const half_t* QG = WG + (size_t)M_ * 512; const half_t* UG = QG + (size_t)M_ * 512;
  const half_t* KTG = UG + (size_t)M_ * 512; const half_t* AQK = (const half_t*)(ws + WS_AQK); const float* GL = (const float*)(ws + WS_GL);
  int tid_ = threadIdx.x; asm volatile("" : "+v"(tid_));
  const int tid = tid_, wid = tid >> 6, lane = tid & 63, l16 = lane & 15, quad = lane >> 4;
  const int b = bh >> 2, h = bh & 3;
  half_t* Wl = (half_t*)smem;
  half_t* Ql = (half_t*)(smem + 17408);
  half_t* Al = (half_t*)(smem + 34816);
  half_t* Ktl = (half_t*)(smem + 44032);
  half_t* Ul = (half_t*)(smem + 62464);
  float* ost = (float*)(smem + 79872);
  f32x4 St[8];
#pragma unroll
  for (int i = 0; i < 8; ++i) St[i] = f32x4{0.f, 0.f, 0.f, 0.f};
  h8 rw[2], rq[2], ru[2], rk[2], ra, rz[2], zc[2]; float egl_next = 0.f;
  auto prefetch = [&](int n) {
    long m0 = (long)b * T_ + n * 64; size_t cid = (size_t)bh * 64 + n;
    { const half_t* zp0 = proj + (m0 + (tid >> 3)) * PL + 512 + h * 128 + (tid & 7) * 16; rz[0] = *(const h8*)zp0; rz[1] = *(const h8*)(zp0 + 8); }
#pragma unroll
    for (int e = 0; e < 2; ++e) {
      int id = tid + NTH * e; int row = id >> 4, c16 = id & 15;
      rw[e] = *(const h8*)(WG + (m0 + row) * 512 + h * 128 + c16 * 8);
      rq[e] = *(const h8*)(QG + (m0 + row) * 512 + h * 128 + c16 * 8);
      ru[e] = *(const h8*)(UG + (m0 + row) * 512 + h * 128 + c16 * 8);
      rk[e] = *(const h8*)(KTG + cid * 8192 + id * 8);
    }
    ra = *(const h8*)(AQK + cid * 4096 + tid * 8);
    { int zoff = 0; asm volatile("" : "+v"(zoff)); egl_next = GL[cid + zoff]; }
  };
  prefetch(0);
  const float* og = p.gdn_out_norm + l * 128;
  for (int n = 0; n < 64; ++n) {
#pragma unroll
    for (int e = 0; e < 2; ++e) {
      int id = tid + NTH * e; int row = id >> 4, c16 = id & 15;
      *(h8*)(Wl + row * 136 + c16 * 8) = rw[e];
      *(h8*)(Ql + row * 136 + c16 * 8) = rq[e];
      *(h8*)(Ul + row * 136 + c16 * 8) = ru[e];
      int krow = id >> 3, kc = id & 7;
      *(h8*)(Ktl + krow * 72 + kc * 8) = rk[e];
    }
    { int row = tid >> 3, kc = tid & 7; *(h8*)(Al + row * 72 + kc * 8) = ra; }
    zc[0] = rz[0]; zc[1] = rz[1];
    const float egl = egl_next;
    __syncthreads();
    if (n + 1 < 64) prefetch(n + 1);
    h8 Sf[4];
#pragma unroll
    for (int s = 0; s < 4; ++s)
#pragma unroll
      for (int i = 0; i < 4; ++i) { Sf[s][i] = (half_t)St[2 * s][i]; Sf[s][4 + i] = (half_t)St[2 * s + 1][i]; }
#define SCHEDB __builtin_amdgcn_sched_barrier(0)
    f32x4 vn[4];
    {
      h8 fa[16]; float uu[16];
#pragma unroll
      for (int ct = 0; ct < 4; ++ct)
#pragma unroll
        for (int s = 0; s < 4; ++s) {
          h4 w0 = *(const h4*)(Wl + (16 * ct + l16) * 136 + 32 * s + 4 * quad);
          h4 w1 = *(const h4*)(Wl + (16 * ct + l16) * 136 + 32 * s + 16 + 4 * quad);
          fa[ct * 4 + s] = cat44(w0, w1);
        }
#pragma unroll
      for (int ct = 0; ct < 4; ++ct)
#pragma unroll
        for (int i = 0; i < 4; ++i) uu[ct * 4 + i] = (float)Ul[(16 * ct + 4 * quad + i) * 136 + 16 * wid + l16];
      SCHEDB;
      {
        f32x4 aa[4];
#pragma unroll
        for (int ct = 0; ct < 4; ++ct) aa[ct] = f32x4{0.f, 0.f, 0.f, 0.f};
#pragma unroll
        for (int s = 0; s < 4; ++s)
#pragma unroll
          for (int ct = 0; ct < 4; ++ct) aa[ct] = mfma16(fa[ct * 4 + s], Sf[s], aa[ct]);
#pragma unroll
        for (int ct = 0; ct < 4; ++ct)
#pragma unroll
          for (int i = 0; i < 4; ++i) vn[ct][i] = uu[ct * 4 + i] - aa[ct][i];
      }
      SCHEDB;
    }
    h8 Vf[2];
#pragma unroll
    for (int s = 0; s < 2; ++s)
#pragma unroll
      for (int i = 0; i < 4; ++i) { Vf[s][i] = (half_t)vn[2 * s][i]; Vf[s][4 + i] = (half_t)vn[2 * s + 1][i]; }
    f32x4 oacc[4];
    {
      h8 fq[16];
#pragma unroll
      for (int ct = 0; ct < 4; ++ct)
#pragma unroll
        for (int s = 0; s < 4; ++s) {
          h4 q0 = *(const h4*)(Ql + (16 * ct + l16) * 136 + 32 * s + 4 * quad);
          h4 q1 = *(const h4*)(Ql + (16 * ct + l16) * 136 + 32 * s + 16 + 4 * quad);
          fq[ct * 4 + s] = cat44(q0, q1);
        }
      SCHEDB;
#pragma unroll
      for (int ct = 0; ct < 4; ++ct) oacc[ct] = f32x4{0.f, 0.f, 0.f, 0.f};
#pragma unroll
      for (int s = 0; s < 4; ++s)
#pragma unroll
        for (int ct = 0; ct < 4; ++ct) oacc[ct] = mfma16(fq[ct * 4 + s], Sf[s], oacc[ct]);
      SCHEDB;
    }
    {
      h8 fb[8];
#pragma unroll
      for (int ct = 0; ct < 4; ++ct)
#pragma unroll
        for (int s = 0; s < 2; ++s) {
          h4 a0 = *(const h4*)(Al + (16 * ct + l16) * 72 + 32 * s + 4 * quad);
          h4 a1 = *(const h4*)(Al + (16 * ct + l16) * 72 + 32 * s + 16 + 4 * quad);
          fb[ct * 2 + s] = cat44(a0, a1);
        }
      SCHEDB;
#pragma unroll
      for (int s = 0; s < 2; ++s)
#pragma unroll
        for (int ct = 0; ct < 4; ++ct) oacc[ct] = mfma16(fb[ct * 2 + s], Vf[s], oacc[ct]);
#pragma unroll
      for (int ct = 0; ct < 4; ++ct)
#pragma unroll
        for (int i = 0; i < 4; ++i) ost[(16 * ct + 4 * quad + i) * 132 + 16 * wid + l16] = oacc[ct][i];
      SCHEDB;
    }
    {
      h8 fk[16];
#pragma unroll
      for (int Tt = 0; Tt < 8; ++Tt)
#pragma unroll
        for (int s = 0; s < 2; ++s) {
          h4 k0 = *(const h4*)(Ktl + (16 * Tt + l16) * 72 + 32 * s + 4 * quad);
          h4 k1 = *(const h4*)(Ktl + (16 * Tt + l16) * 72 + 32 * s + 16 + 4 * quad);
          fk[Tt * 2 + s] = cat44(k0, k1);
        }
      SCHEDB;
#pragma unroll
      for (int Tt = 0; Tt < 8; ++Tt) St[Tt] = St[Tt] * egl;
#pragma unroll
      for (int s = 0; s < 2; ++s)
#pragma unroll
        for (int Tt = 0; Tt < 8; ++Tt) St[Tt] = mfma16(fk[Tt * 2 + s], Vf[s], St[Tt]);
      SCHEDB;
    }
    __syncthreads();
    {
      int r = tid >> 3, seg = tid & 7; long m = (long)b * T_ + n * 64 + r;
      float o[16]; float ss = 0.f;
#pragma unroll
      for (int e = 0; e < 16; ++e) { o[e] = ost[r * 132 + seg * 16 + e]; ss += o[e] * o[e]; }
      ss += __shfl_xor(ss, 1); ss += __shfl_xor(ss, 2); ss += __shfl_xor(ss, 4);
      float rr = rsqrtf(ss * (1.f / 128.f) + EPS);
      half_t* zp = proj + m * PL + 512 + h * 128 + seg * 16;
      h8 z0 = zc[0], z1 = zc[1], o0, o1;
#pragma unroll
      for (int e = 0; e < 8; ++e) {
        o0[e] = (half_t)(o[e] * rr * og[seg * 16 + e] * silu_fast((float)z0[e]));
        o1[e] = (half_t)(o[8 + e] * rr * og[seg * 16 + 8 + e] * silu_fast((float)z1[e]));
      }
      half_t* op = dry ? zp + (1792 - 512) : zp;
      *(h8*)op = o0; *(h8*)(op + 8) = o1;
    }
  }
  __syncthreads();
}

#define XB_TMO      128
#define XB_XCNT(j)  (256  + 64 * (j))
#define XB_XSUB(j)  (1280 + 64 * (j))
#define XB_XGEN(j)  (2304 + 64 * (j))
#define XB_TOP      3328
#define XB_TOPGEN   3392
#define XCD_BAR_WORDS 3456
#define XB_SPIN_CAP (1u << 18)
#define LAS __attribute__((address_space(3)))

__device__ __forceinline__ unsigned xb_ld(unsigned* p)              { return __hip_atomic_load(p, __ATOMIC_RELAXED, __HIP_MEMORY_SCOPE_AGENT); }
__device__ __forceinline__ unsigned xb_add(unsigned* p, unsigned v) { return __hip_atomic_fetch_add(p, v, __ATOMIC_RELAXED, __HIP_MEMORY_SCOPE_AGENT); }
__device__ __forceinline__ unsigned xb_xcc_id() { return (unsigned)__builtin_amdgcn_s_getreg((3 << 11) | 20) & 0xFu; }
#define XB_SPIN(cond, bar) do { unsigned _sp = 0; while (cond) { __builtin_amdgcn_s_sleep(1); \
    if ((++_sp & 255u) == 0u) { if (xb_ld(&(bar)[XB_TMO])) break; if (_sp > XB_SPIN_CAP) { atomicAdd(&(bar)[XB_TMO], 1u); break; } } } } while (0)

struct XcdBarrier {
    unsigned* bar; unsigned x;
    volatile LAS unsigned* st;
};

__device__ __forceinline__ XcdBarrier xcd_barrier_post(unsigned* bar, volatile LAS unsigned* st) {
    XcdBarrier b; b.bar = bar; b.x = xb_xcc_id(); b.st = st;
    if (threadIdx.x == 0) (void)xb_add(&bar[XB_XCNT(b.x)], 1u);
    return b;
}
__device__ __forceinline__ void xcd_barrier_complete(unsigned* bar, unsigned x, unsigned& nloc, unsigned& nx) {
    const unsigned G = gridDim.x * gridDim.y * gridDim.z;
    unsigned sum, cnt, mine, sp = 0u;
    for (;;) {
        sum = 0u; cnt = 0u; mine = 0u;
#pragma unroll
        for (unsigned j = 0; j < 16; ++j) { const unsigned c = xb_ld(&bar[XB_XCNT(j)]); sum += c; cnt += (c > 0u) ? 1u : 0u; mine = (j == x) ? c : mine; }
        if (sum == G) break;
        __builtin_amdgcn_s_sleep(1);
        if ((++sp & 255u) == 0u) { if (xb_ld(&bar[XB_TMO])) break; if (sp > XB_SPIN_CAP) { atomicAdd(&bar[XB_TMO], 1u); break; } }
    }
    nloc = mine > 0u ? mine : 1u; nx = cnt > 0u ? cnt : 1u;
}

__device__ __forceinline__ void xcd_barrier(const XcdBarrier& b) {
    asm volatile("s_waitcnt vmcnt(0)" ::: "memory");
    __syncthreads();
    if (threadIdx.x == 0) {
        unsigned* bar = b.bar;
        __builtin_amdgcn_s_waitcnt(0);
        unsigned nloc = b.st[0], nx = b.st[1];
        if (nloc == 0u) { xcd_barrier_complete(bar, b.x, nloc, nx); b.st[0] = nloc; b.st[1] = nx; }
        const unsigned old = xb_add(&bar[XB_XSUB(b.x)], 1u);
        const unsigned gen = old / nloc;
        if (old + 1u == (gen + 1u) * nloc) {
            __builtin_amdgcn_fence(__ATOMIC_RELEASE, "agent");
            asm volatile("s_waitcnt vmcnt(0)" ::: "memory");
            const unsigned og = xb_add(&bar[XB_TOP], 1u);
            const unsigned tg = og / nx;
            if (og + 1u == (tg + 1u) * nx) xb_add(&bar[XB_TOPGEN], 1u);
            else XB_SPIN(xb_ld(&bar[XB_TOPGEN]) == tg, bar);
            __builtin_amdgcn_fence(__ATOMIC_ACQUIRE, "agent");
            xb_add(&bar[XB_XGEN(b.x)], 1u);
            asm volatile("s_waitcnt vmcnt(0)" ::: "memory");
        } else {
            XB_SPIN(xb_ld(&bar[XB_XGEN(b.x)]) == gen, bar);
            __builtin_amdgcn_fence(__ATOMIC_ACQUIRE, "agent");
            asm volatile("s_waitcnt vmcnt(0)" ::: "memory");
        }
    }
    __syncthreads();
}


DI void grid_barrier(unsigned* cnt, unsigned target) {
  asm volatile("s_waitcnt vmcnt(0) lgkmcnt(0)" ::: "memory");
  __syncthreads();
  if (threadIdx.x == 0) {
    __builtin_amdgcn_fence(__ATOMIC_RELEASE, "agent");
    asm volatile("s_waitcnt vmcnt(0)" ::: "memory");
    __hip_atomic_fetch_add(cnt, 1u, __ATOMIC_RELAXED, __HIP_MEMORY_SCOPE_AGENT);
    while (__hip_atomic_load(cnt, __ATOMIC_RELAXED, __HIP_MEMORY_SCOPE_AGENT) < target) __builtin_amdgcn_s_sleep(1);
    __builtin_amdgcn_fence(__ATOMIC_ACQUIRE, "agent");
    asm volatile("s_waitcnt vmcnt(0) lgkmcnt(0)" ::: "memory");
  }
  __syncthreads();
}

__global__ void __launch_bounds__(NTH, 2) fwd_mega(Params p) {
  extern __shared__ __attribute__((aligned(16))) char smem[];
  cg::grid_group grid = cg::this_grid();
#ifndef PROBE_K
#define PROBE_K -1
#endif
#ifndef PROBE_K2
#define PROBE_K2 -1
#endif
  bool first = true; int repflag = 0; int nbar = 0;
  char* const ws_base = p.ws;
  volatile LAS unsigned* xst = (volatile LAS unsigned*)(smem + LDS_BYTES - 16);
  if (threadIdx.x < 4) xst[threadIdx.x] = 0u;
  __syncthreads();
  XcdBarrier xb = xcd_barrier_post((unsigned*)(p.ws + WS_END), xst);
  for (int ph = p.phase_lo; ph < p.phase_hi;) {
    if (ph % 9 == 2 || ph % 9 == 4 || (ph % 9 == 0 && ph > 0)) { ++ph; continue; }
    if (!first) {
      if (nbar == 0) grid.sync();
      else xcd_barrier(xb);
      ++nbar;
    }
    first = false;
    const int ph_cur = ph;
    {
      const int kk = ph % 9;
      if ((kk == PROBE_K || kk == PROBE_K2) && !repflag && (PROBE_K != 6 || ph < 9)) { repflag = 1; }
      else if (PROBE_K == 15 && kk == 5 && !repflag) { repflag = 1; ph -= 4; }
      else { if (PROBE_K != 15 || kk == 5) repflag = 0; ++ph; }
    }
    { size_t zoffs = 0; asm volatile("" : "+s"(zoffs)); p.ws = ws_base + zoffs; }
    char* ws = p.ws;
    const int l = ph_cur / 9, k = ph_cur % 9;
    if (k == 0) {
      for (int ll = 0; ll < 4; ++ll) phase_weights(p, ll, smem);
    } else if (k == 1) {
      GArgs g{}; g.A = (const half_t*)(ws + WS_XH + 8192); g.lda = 1024; g.Bt = (const half_t*)(ws + wset(l) + WS_WIN); g.K = 1024; g.nM = 128; g.nN = 14;
      g.rss = (const float*)(ws + WS_RSS); g.outh = (half_t*)(ws + WS_PROJ); g.ldo = PL;
      g.cs = (const float*)(ws + WS_COS); g.sn = (const float*)(ws + WS_SIN); g.qg = p.q_norm + l * 64;
      g.kg1 = p.k_norm + (l * 3 + 1) * 64; g.kg2 = p.k_norm + (l * 3 + 2) * 64;
      g.kcr = (half_t*)(ws + WS_KCR); g.vcr = (half_t*)(ws + WS_VCR); g.vst = (half_t*)(ws + WS_VST); g.vwt = (half_t*)(ws + WS_VWT);
      gemm_phase<EPI_IN>(g, smem);
    } else if (k == 3) {
      GArgs g{}; g.lda = 1024; g.K = 2048; g.nM = 16; g.nN = 1; g.ldo = 256;
      for (int it = blockIdx.x; it < 32; it += gridDim.x) {
        int kv = it >> 4, pm = it & 15;
        g.A = (const half_t*)(ws + (kv ? WS_VCR : WS_KCR)); g.Bt = (const half_t*)(ws + wset(l) + WS_WC1) + (size_t)kv * 256 * 2048;
        g.c1p = (const float*)(ws + wset(l) + WS_C1P) + kv * 256; g.kv = kv;
        g.w2t = (const half_t*)(ws + w2t_off(l)) + (size_t)kv * 64 * 256; g.kc = (half_t*)(ws + WS_KC); g.vct = (half_t*)(ws + WS_VCT); g.kg0 = p.k_norm + (l * 3 + 0) * 64;
        gemm_tile<EPI_CMP>(g, pm, 0, smem);
      }
#ifndef NOGDN
      if (blockIdx.x < 32) { for (int it = blockIdx.x * 6; it < blockIdx.x * 6 + 6; ++it) gdn_pre_item(p, l, it, smem); }
      else { for (int it = 192 + (blockIdx.x - 32); it < 2048; it += gridDim.x - 32) gdn_pre_item(p, l, it, smem); }
#endif
    } else if (k == 5) {
#ifndef PROBE_DRY
#define PROBE_DRY 0
#endif
      for (int pass = (PROBE_DRY ? 0 : 1); pass < 2; ++pass) {
        const int dry = (pass == 0);
        if (pass == 1 && PROBE_DRY) grid.sync();
        if (blockIdx.x < 32) { if (!dry || PROBE_DRY == 1) gdn_scan_item(p, l, blockIdx.x, smem, dry); }
        else if (!dry || PROBE_DRY == 2) {
          const int nb = gridDim.x - 32, bi = blockIdx.x - 32;
          for (int r = 0; r * nb < 1024; ++r) { int it = r * nb + ((r & 1) ? nb - 1 - bi : bi); if (it < 1024) nsa_item(p, l, it, smem, dry); }
        }
      }
    } else if (k == 6) {
      GArgs g{}; g.A = (const half_t*)(ws + WS_PROJ); g.lda = PL; g.Bt = (const half_t*)(ws + wset(l) + WS_WOUT); g.K = 1024; g.nM = 128; g.nN = 4;
      g.xout = nullptr; g.rss_out = (float*)(ws + WS_RSS);
      g.outh = (half_t*)(ws + WS_XH + 8192); g.ldo = 1024;
      gemm_phase<EPI_RES>(g, smem);
    } else if (k == 7) {
      GArgs g{}; g.A = (const half_t*)(ws + WS_XH + 8192); g.lda = 1024; g.Bt = (const half_t*)(ws + wset(l) + WS_WUP); g.K = 1024; g.nM = 128; g.nN = 22;
      g.hf = (half_t*)(ws + WS_HF); g.hl = (half_t*)(ws + WS_HL);
      g.rss = (const float*)(ws + WS_RSS); g.outh = (half_t*)(ws + WS_PROJ); g.ldo = NFF;
      g.convw = p.ffn_conv_w + (size_t)l * 3 * 5632; g.convb = p.ffn_conv_b + (size_t)l * 5632;
      gemm_phase<EPI_UP>(g, smem);
    } else {
      GArgs g{}; g.A = (const half_t*)(ws + WS_PROJ); g.lda = NFF; g.Bt = (const half_t*)(ws + wset(l) + WS_WDOWN); g.K = 2816; g.nM = 128; g.nN = 4;
      g.hf = (half_t*)(ws + WS_HF); g.hl = (half_t*)(ws + WS_HL); g.convw = p.ffn_conv_w + (size_t)l * 3 * 5632; g.convb = p.ffn_conv_b + (size_t)l * 5632;
      g.xout = (l < 3) ? nullptr : p.out; g.rss_out = (float*)(ws + WS_RSS);
      g.outh = (half_t*)(ws + WS_XH + 8192); g.ldo = 1024;
      gemm_phase<EPI_RES>(g, smem);
    }
  }
}

extern "C" void kernel_launch(void* const* d_in, const int* in_sizes, int n_in, void* d_out, int out_size, void* d_ws, size_t ws_size,
                              hipStream_t stream) {
  static int grid_blocks = 0;
  if (!grid_blocks) {
    if (ws_size < WS_END + XCD_BAR_WORDS * 4) { fprintf(stderr, "kernel_launch: workspace too small: %zu < %zu\n", ws_size, (size_t)WS_END); grid_blocks = -1; }
    else {
      int dev = 0, cus = 0, per_cu = 0;
      hipGetDevice(&dev);
      hipDeviceGetAttribute(&cus, hipDeviceAttributeMultiprocessorCount, dev);
      hipFuncSetAttribute((const void*)fwd_mega, hipFuncAttributeMaxDynamicSharedMemorySize, LDS_BYTES);
      hipOccupancyMaxActiveBlocksPerMultiprocessor(&per_cu, fwd_mega, NTH, LDS_BYTES);
      if (per_cu < 1) per_cu = 1;
      grid_blocks = cus < 64 ? -1 : cus;
    }
  }
  if (grid_blocks <= 0) return;
  Params p{};
  p.x = (const float*)d_in[0]; p.pos = (const int*)d_in[1]; p.attn_norm = (const float*)d_in[2]; p.w_in = (const float*)d_in[3];
  p.q_norm = (const float*)d_in[4]; p.k_norm = (const float*)d_in[5]; p.cmp_pe = (const float*)d_in[6]; p.cmp_w1 = (const float*)d_in[7];
  p.cmp_w2 = (const float*)d_in[8]; p.nsa_out_norm = (const float*)d_in[9]; p.gdn_conv_w = (const float*)d_in[10];
  p.gdn_a_log = (const float*)d_in[11]; p.gdn_dt_bias = (const float*)d_in[12]; p.gdn_out_norm = (const float*)d_in[13];
  p.w_out = (const float*)d_in[14]; p.ffn_norm = (const float*)d_in[15]; p.w_up = (const float*)d_in[16]; p.ffn_conv_w = (const float*)d_in[17];
  p.ffn_conv_b = (const float*)d_in[18]; p.w_down = (const float*)d_in[19];
  p.out = (float*)d_out; p.ws = (char*)d_ws; p.phase_lo = 0; p.phase_hi = 36;
  (void)hipMemsetAsync((char*)d_ws + WS_END, 0, XCD_BAR_WORDS * 4, stream);
  void* args[] = {&p};
  hipError_t e = hipLaunchCooperativeKernel((void*)fwd_mega, dim3(grid_blocks), dim3(NTH), args, LDS_BYTES, stream);
  if (e != hipSuccess) fprintf(stderr, "cooperative launch failed: %s (grid %d)\n", hipGetErrorString(e), grid_blocks);
}
```

```cpp
#include <hip/hip_runtime.h>
#include <hip/hip_cooperative_groups.h>
#include <cstdio>
#include <cstdint>
namespace cg = cooperative_groups;

typedef _Float16 half_t;
typedef _Float16 h8 __attribute__((ext_vector_type(8)));
typedef _Float16 h4 __attribute__((ext_vector_type(4)));
typedef float f32x4 __attribute__((ext_vector_type(4)));
typedef float f32x16 __attribute__((ext_vector_type(16)));
#define DI __device__ __forceinline__

constexpr int M_ = 32768, T_ = 4096, D_ = 1024, PL = 3584, NFF = 2816;
constexpr int NTH = 512;
constexpr int LDS_BYTES = 163840;
constexpr float EPS = 1e-6f;

constexpr size_t AL(size_t x) { return (x + 255) & ~(size_t)255; }
constexpr size_t WS_WIN = 0;
constexpr size_t WS_WOUT = WS_WIN + AL((size_t)PL * 1024 * 2);
constexpr size_t WS_WUP = WS_WOUT + AL((size_t)1024 * 1024 * 2);
constexpr size_t WS_WDOWN = WS_WUP + AL((size_t)5632 * 1024 * 2);
constexpr size_t WS_WC1 = WS_WDOWN + AL((size_t)1024 * 2816 * 2);
constexpr size_t WS_C1P = WS_WC1 + AL((size_t)2 * 256 * 2048 * 2);
constexpr size_t WS_COS = WS_C1P + AL((size_t)16 * 512 * 4);
constexpr size_t WS_SIN = WS_COS + AL((size_t)M_ * 8 * 4);
constexpr size_t WS_RSS = WS_SIN + AL((size_t)M_ * 8 * 4);
constexpr size_t WS_XH = WS_RSS + AL((size_t)M_ * 4 * 4);
constexpr size_t WS_PROJ = WS_XH + AL((size_t)(M_ + 264) * 1024 * 2);
constexpr size_t WS_KCR = WS_PROJ + AL((size_t)M_ * PL * 2);
constexpr size_t WS_VCR = WS_KCR + AL(((size_t)16 * 4096 * 64 + 4096) * 2);
constexpr size_t WS_HID = WS_VCR + AL(((size_t)16 * 4096 * 64 + 4096) * 2);
constexpr size_t WS_KC = WS_HID + AL((size_t)2 * 4096 * 256 * 2);
constexpr size_t WS_VCT = WS_KC + AL((size_t)16 * 256 * 64 * 2);
constexpr size_t WS_VST = WS_VCT + AL((size_t)16 * 256 * 64 * 2);
constexpr size_t WS_VWT = WS_VST + AL((size_t)16 * 64 * 4096 * 2);
constexpr size_t WS_WG = WS_VWT + AL((size_t)16 * 64 * 4096 * 2);
constexpr size_t WS_QG = WS_WG + AL((size_t)M_ * 512 * 2);
constexpr size_t WS_UG = WS_QG + AL((size_t)M_ * 512 * 2);
constexpr size_t WS_KTG = WS_UG + AL((size_t)M_ * 512 * 2);
constexpr size_t WS_AQK = WS_KTG + AL((size_t)2048 * 128 * 64 * 2);
constexpr size_t WS_GL = WS_AQK + AL((size_t)2048 * 64 * 64 * 2);
constexpr size_t WS_END = WS_GL + AL((size_t)2048 * 4);

__constant__ float ROPE_INV[8] = {1.000000000e+00f,1.939227432e-01f,3.760603070e-02f,7.292664610e-03f,1.414213562e-03f,2.742481884e-04f,5.318295734e-05f,1.031338525e-05f};

constexpr size_t WSET_STRIDE = AL(WS_COS + 65536);
constexpr size_t WS_HF = WS_WG + 4 * WSET_STRIDE;
constexpr size_t WS_HL = WS_HF + AL((size_t)128 * 2 * 5632 * 2);
constexpr size_t WS_KST = WS_HL + AL((size_t)128 * 2 * 5632 * 2);
static_assert(WS_KST + (size_t)16 * 64 * 4096 * 2 <= WS_AQK, "halo / key-tile buffers must fit the free region");
DI size_t wset(int l) { return WS_WG + (size_t)l * WSET_STRIDE; }
DI size_t w2t_off(int l) { return WS_WG + (size_t)l * WSET_STRIDE + WS_COS; }

struct Params {
  const float* x; const int* pos; const float* attn_norm; const float* w_in; const float* q_norm; const float* k_norm;
  const float* cmp_pe; const float* cmp_w1; const float* cmp_w2; const float* nsa_out_norm; const float* gdn_conv_w;
  const float* gdn_a_log; const float* gdn_dt_bias; const float* gdn_out_norm; const float* w_out; const float* ffn_norm;
  const float* w_up; const float* ffn_conv_w; const float* ffn_conv_b; const float* w_down;
  float* out; char* ws; int phase_lo; int phase_hi;
};

DI float sigm(float x) { return 1.f / (1.f + expf(-x)); }
DI float siluf(float x) { return x / (1.f + expf(-x)); }
DI float silu_fast(float x) { return x * __frcp_rn(1.f + __expf(-x)); }
DI f32x16 mfma32(h8 a, h8 b, f32x16 c) { return __builtin_amdgcn_mfma_f32_32x32x16_f16(a, b, c, 0, 0, 0); }
DI f32x4 mfma16(h8 a, h8 b, f32x4 c) { return __builtin_amdgcn_mfma_f32_16x16x32_f16(a, b, c, 0, 0, 0); }
DI h8 cat44(h4 a, h4 b) { return __builtin_shufflevector(a, b, 0, 1, 2, 3, 4, 5, 6, 7); }
DI char* lws(const Params& p) { char* w = p.ws; asm volatile("" : "+s"(w)); return w; }
DI int ltid() { int t = threadIdx.x; asm volatile("" : "+v"(t)); return t; }
typedef _Float16 h2 __attribute__((ext_vector_type(2)));
#define EXP2(x) __builtin_amdgcn_exp2f(x)
DI int crow(int reg, int hf) { return (reg & 3) + 8 * (reg >> 2) + 4 * hf; }

DI int map_in(int c) {
  if (c < 512) return c;
  if (c < 1024) return 2848 + (c - 512);
  if (c < 1792) return 512 + (c - 1024);
  if (c < 3328) return 1304 + (c - 1792);
  if (c < 3352) return 1280 + (c - 3328);
  if (c < 3360) return 2840 + (c - 3352);
  return -1;
}
DI int map_up(int c) { int n = c >> 8, j = c & 255; return j < 128 ? n * 128 + j : 2816 + n * 128 + (j - 128); }

template <int MAP>
__device__ void conv_transpose(const float* __restrict__ W, int K, int No, half_t* __restrict__ Wt, int Np, char* smem, const float* __restrict__ rs = nullptr) {
  float* tile = (float*)smem;
  const int tid = ltid();
  const int ntn = Np / 64, ntk = K / 64;
  for (int t = blockIdx.x; t < ntn * ntk; t += gridDim.x) {
    int tn = t % ntn, tk = t / ntn;
#pragma unroll
    for (int e = 0; e < 8; ++e) {
      int idx = tid + NTH * e; int kk = idx >> 6, nn = idx & 63;
      int np = tn * 64 + nn;
      int on = MAP == 1 ? map_in(np) : (MAP == 2 ? map_up(np) : np);
      float v = on >= 0 ? W[(size_t)(tk * 64 + kk) * No + on] : 0.f;
      if (rs) v *= rs[tk * 64 + kk];
      tile[kk * 65 + nn] = v;
    }
    __syncthreads();
    {
      int nn = tid >> 3, kg = tid & 7; h8 v;
#pragma unroll
      for (int j = 0; j < 8; ++j) v[j] = (half_t)tile[(kg * 8 + j) * 65 + nn];
      *(h8*)(Wt + (size_t)(tn * 64 + nn) * K + tk * 64 + kg * 8) = v;
    }
    __syncthreads();
  }
}

__device__ void phase_weights(const Params& p, int l, char* smem) {
  char* ws = p.ws + wset(l);
  conv_transpose<1>(p.w_in + (size_t)l * 1024 * 3360, 1024, 3360, (half_t*)(ws + WS_WIN), PL, smem, p.attn_norm + l * 1024);
  conv_transpose<0>(p.w_out + (size_t)l * 1024 * 1024, 1024, 1024, (half_t*)(ws + WS_WOUT), 1024, smem);
  conv_transpose<2>(p.w_up + (size_t)l * 1024 * 5632, 1024, 5632, (half_t*)(ws + WS_WUP), 5632, smem, p.ffn_norm + l * 1024);
  conv_transpose<0>(p.w_down + (size_t)l * 2816 * 1024, 2816, 1024, (half_t*)(ws + WS_WDOWN), 1024, smem);
  for (int kv = 0; kv < 2; ++kv)
    conv_transpose<0>(p.cmp_w1 + (size_t)(l * 2 + kv) * 2048 * 256, 2048, 256, (half_t*)(ws + WS_WC1) + (size_t)kv * 256 * 2048, 256, smem);
  for (int kv = 0; kv < 2; ++kv)
    conv_transpose<0>(p.cmp_w2 + (size_t)(l * 2 + kv) * 256 * 64, 256, 64, (half_t*)(p.ws + w2t_off(l)) + (size_t)kv * 64 * 256, 64, smem);
  float* c1p = (float*)(ws + WS_C1P);
  for (int it = blockIdx.x; it < 32; it += gridDim.x) {
    int kv = it >> 4, kc = it & 15; int n = ltid();
    if (n < 256) {
      const float* pe = p.cmp_pe + (size_t)(l * 2 + kv) * 2048 + kc * 128;
      const float* w1 = p.cmp_w1 + ((size_t)(l * 2 + kv) * 2048 + kc * 128) * 256 + n;
      float s = 0.f;
      for (int k = 0; k < 128; ++k) s += pe[k] * w1[(size_t)k * 256];
      c1p[kc * 512 + kv * 256 + n] = s;
    }
  }
  if (l == 0) {
    half_t* xh = (half_t*)(p.ws + WS_XH + 8192); float* rss = (float*)(p.ws + WS_RSS);
    float* cs = (float*)(p.ws + WS_COS); float* sn = (float*)(p.ws + WS_SIN);
    const int tidw = ltid(); const int wid = tidw >> 6, lane = tidw & 63;
    for (int row = blockIdx.x * 8 + wid; row < M_; row += gridDim.x * 8) {
      const float* xr = p.x + (size_t)row * 1024;
      float ss = 0.f;
#pragma unroll
      for (int e = 0; e < 2; ++e) {
        int c = (e * 64 + lane) * 8;
        float4 a = *(const float4*)(xr + c), b = *(const float4*)(xr + c + 4);
        float4 ga = {1.f, 1.f, 1.f, 1.f}, gb = {1.f, 1.f, 1.f, 1.f};
        ss += a.x * a.x + a.y * a.y + a.z * a.z + a.w * a.w + b.x * b.x + b.y * b.y + b.z * b.z + b.w * b.w;
        h8 v; v[0] = (half_t)(a.x * ga.x); v[1] = (half_t)(a.y * ga.y); v[2] = (half_t)(a.z * ga.z); v[3] = (half_t)(a.w * ga.w);
        v[4] = (half_t)(b.x * gb.x); v[5] = (half_t)(b.y * gb.y); v[6] = (half_t)(b.z * gb.z); v[7] = (half_t)(b.w * gb.w);
        *(h8*)(xh + (size_t)row * 1024 + c) = v;
      }
#pragma unroll
      for (int o = 32; o >= 1; o >>= 1) ss += __shfl_xor(ss, o);
      if (lane == 0) { float4 r; r.x = ss; r.y = 0.f; r.z = 0.f; r.w = 0.f; *(float4*)(rss + (size_t)row * 4) = r; }
      if (lane < 8) {
        float inv = ROPE_INV[lane];
        float ang = (float)p.pos[row] * inv;
        cs[(size_t)row * 8 + lane] = cosf(ang);
        sn[(size_t)row * 8 + lane] = sinf(ang);
      }
    }
  }
}

DI int lds_byte(int r, int c) {
  int st = (r >> 4) * 2 + (c >> 5), rr = r & 15, cc = c & 31, ob = rr * 64 + cc * 2;
  return st * 1024 + (ob ^ (((ob >> 9) & 1) << 5));
}
DI void stage_rc(int b, int& R, int& C) {
  int st = b / 1024, sb = b % 1024, swz = sb ^ (((sb >> 9) & 1) << 5);
  R = (st >> 1) * 16 + swz / 64; C = (st & 1) * 32 + (swz % 64) / 2;
}

DI void gemm_kloop(const half_t* __restrict__ A0, const half_t* __restrict__ A1, const half_t* __restrict__ Bt0, const half_t* __restrict__ Bt1,
                   const unsigned (&oa)[2], const unsigned (&ob)[2], int nt, char* smem, f32x4 (&acc)[2][2][4][2], const int tid) {
  const int wid = tid >> 6, lane = tid & 63, wr = wid >> 2, wc = wid & 3, fr = lane & 15, fq = lane >> 4;
  constexpr int HTB = 128 * 64 * 2;
#define SA(b, h) (smem + ((b) * 2 + (h)) * HTB)
#define SB(b, h) (smem + (4 + (b) * 2 + (h)) * HTB)
#define STAGE(P, BASE, O, kt) do { for (int _i = 0; _i < 2; ++_i) { \
    __builtin_amdgcn_global_load_lds((const unsigned*)((BASE) + (long)(kt) * 64 + (O)[_i]), (unsigned*)((P) + tid * 16 + _i * 8192), 16, 0, 0); } } while (0)
#define LDA(dst, b, h) for (int m = 0; m < 4; ++m) for (int k = 0; k < 2; ++k) \
    dst[m][k] = *reinterpret_cast<const h8*>(SA(b, h) + lds_byte(wr * 64 + m * 16 + fr, k * 32 + fq * 8))
#define LDB(dst, b, h) for (int n = 0; n < 2; ++n) for (int k = 0; k < 2; ++k) \
    dst[n][k] = *reinterpret_cast<const h8*>(SB(b, h) + lds_byte(wc * 32 + n * 16 + fr, k * 32 + fq * 8))
#define MMA(ai, bj, At_, Bt_) do { __builtin_amdgcn_s_setprio(1); \
    for (int m = 0; m < 4; ++m) for (int n = 0; n < 2; ++n) for (int k = 0; k < 2; ++k) \
      acc[ai][bj][m][n] = mfma16(Bt_[n][k], At_[m][k], acc[ai][bj][m][n]); \
    __builtin_amdgcn_s_setprio(0); } while (0)
#define WAIT_V(n) asm volatile("s_waitcnt vmcnt(" #n ")" ::: "memory")
#define WAIT_L(n) asm volatile("s_waitcnt lgkmcnt(" #n ")" ::: "memory")
#define BAR __builtin_amdgcn_s_barrier()
#define SCHED __builtin_amdgcn_sched_barrier(0)
  h8 At[4][2], B0[2][2], B1[2][2];
#pragma unroll
  for (int a = 0; a < 2; ++a) for (int b = 0; b < 2; ++b) for (int m = 0; m < 4; ++m) for (int n = 0; n < 2; ++n) acc[a][b][m][n] = f32x4{0.f, 0.f, 0.f, 0.f};
  STAGE(SB(0, 0), Bt0, ob, 0); STAGE(SA(0, 0), A0, oa, 0);
  STAGE(SB(0, 1), Bt1, ob, 0); STAGE(SA(0, 1), A1, oa, 0);
  if (wr == 1) BAR;
  WAIT_V(4); BAR;
  STAGE(SB(1, 0), Bt0, ob, 1); STAGE(SA(1, 0), A0, oa, 1); STAGE(SB(1, 1), Bt1, ob, 1);
  WAIT_V(6); BAR;
  for (int t = 0; t < nt - 2; t += 2) {
    LDB(B0, 0, 0); SCHED; LDA(At, 0, 0); STAGE(SA(1, 1), A1, oa, t + 1);
    WAIT_L(8); BAR; WAIT_L(0); MMA(0, 0, At, B0); BAR; SCHED;
    LDB(B1, 0, 1); STAGE(SB(0, 0), Bt0, ob, t + 2);
    BAR; WAIT_L(0); MMA(0, 1, At, B1); BAR;
    LDA(At, 0, 1); STAGE(SA(0, 0), A0, oa, t + 2);
    BAR; WAIT_L(0); MMA(1, 0, At, B0); BAR; SCHED;
    STAGE(SB(0, 1), Bt1, ob, t + 2);
    WAIT_V(6); BAR; MMA(1, 1, At, B1); BAR;
    LDB(B0, 1, 0); SCHED; LDA(At, 1, 0); STAGE(SA(0, 1), A1, oa, t + 2);
    WAIT_L(8); BAR; WAIT_L(0); MMA(0, 0, At, B0); BAR; SCHED;
    LDB(B1, 1, 1); STAGE(SB(1, 0), Bt0, ob, t + 3);
    BAR; WAIT_L(0); MMA(0, 1, At, B1); BAR;
    LDA(At, 1, 1); STAGE(SA(1, 0), A0, oa, t + 3);
    BAR; WAIT_L(0); MMA(1, 0, At, B0); BAR; SCHED;
    STAGE(SB(1, 1), Bt1, ob, t + 3);
    WAIT_V(6); BAR; MMA(1, 1, At, B1); BAR;
  }
  { LDB(B0, 0, 0); LDA(At, 0, 0); STAGE(SA(1, 1), A1, oa, nt - 1);
    BAR; WAIT_L(0); MMA(0, 0, At, B0); BAR;
    LDB(B1, 0, 1); BAR; WAIT_L(0); MMA(0, 1, At, B1); BAR;
    LDA(At, 0, 1); WAIT_V(4); BAR; WAIT_L(0); MMA(1, 0, At, B0); MMA(1, 1, At, B1); BAR; }
  { LDB(B0, 1, 0); LDA(At, 1, 0); WAIT_V(2); BAR; WAIT_L(0); MMA(0, 0, At, B0); BAR;
    LDB(B1, 1, 1); WAIT_V(0); BAR; WAIT_L(0); MMA(0, 1, At, B1); BAR;
    LDA(At, 1, 1); BAR; WAIT_L(0); MMA(1, 0, At, B0); MMA(1, 1, At, B1); BAR; }
  if (wr == 0) BAR;
#undef SA
#undef SB
#undef STAGE
#undef LDA
#undef LDB
#undef MMA
#undef WAIT_V
#undef WAIT_L
#undef BAR
#undef SCHED
}

enum { EPI_IN = 0, EPI_RES = 1, EPI_UP = 2, EPI_CMP = 3 };
struct GArgs {
  const half_t* A; long lda; const half_t* Bt; int K; int nM; int nN;
  const float* rss; half_t* outh; long ldo;
  const float* resid; float* xout; const float* gain_next; float* rss_out;
  const float* convw; const float* convb; const float* c1p;
  const float* cs; const float* sn; const float* qg; const float* kg1; const float* kg2;
  half_t* kcr; half_t* vcr; half_t* vst; half_t* vwt;
  const half_t* w2t; half_t* kc; half_t* vct; const float* kg0; int kv;
  half_t* hf; half_t* hl; half_t* kst;
};

constexpr int TS = 264;

DI void tile_copy_out(const char* smem, half_t* out, long ldo, long grow0, int gcol0, int tid) {
#pragma unroll
  for (int e = 0; e < 16; ++e) {
    int id = tid + NTH * e; int row = id >> 5, c16 = id & 31;
    h8 v = *(const h8*)(smem + (row * TS + c16 * 8) * 2);
    *(h8*)(out + (grow0 + row) * ldo + gcol0 + c16 * 8) = v;
  }
}

template <int EPI>
__device__ void gemm_tile(const GArgs& g, int pm, int pn, char* smem) {
  int tid = ltid();
  const long brow = (long)pm * 256;
  const int bcol = pn * 256;
  if (EPI == EPI_RES) {
    if (g.convw && (pm & 15) != 0) {
      const half_t* L = g.hl + (size_t)(pm - 1) * 2 * 5632; const half_t* F = g.hf + (size_t)pm * 2 * 5632;
      for (int idx = tid; idx < 2816; idx += NTH) {
        int pnn = idx >> 7, cc = idx & 127; int gcol = pnn * 256 + cc, ucol = gcol + 128;
        float wg0 = g.convw[idx], wg1 = g.convw[5632 + idx], wg2 = g.convw[2 * 5632 + idx];
        float wu0 = g.convw[2816 + idx], wu1 = g.convw[5632 + 2816 + idx], wu2 = g.convw[2 * 5632 + 2816 + idx];
        float bgv = g.convb[idx], buv = g.convb[2816 + idx];
        float L0g = (float)L[gcol], L1g = (float)L[5632 + gcol], F0g = (float)F[gcol], F1g = (float)F[5632 + gcol];
        float L0u = (float)L[ucol], L1u = (float)L[5632 + ucol], F0u = (float)F[ucol], F1u = (float)F[5632 + ucol];
        float y0g = wg2 * F0g + wg1 * L1g + wg0 * L0g + bgv, y0u = wu2 * F0u + wu1 * L1u + wu0 * L0u + buv;
        float y1g = wg2 * F1g + wg1 * F0g + wg0 * L1g + bgv, y1u = wu2 * F1u + wu1 * F0u + wu0 * L1u + buv;
        half_t* act = (half_t*)g.A;
        act[brow * NFF + idx] = (half_t)(silu_fast(y0g) * y0u);
        act[(brow + 1) * NFF + idx] = (half_t)(silu_fast(y1g) * y1u);
      }
      asm volatile("s_waitcnt vmcnt(0)" ::: "memory");
      __syncthreads();
    }
  }
  unsigned oa[2], ob[2];
#pragma unroll
  for (int i = 0; i < 2; ++i) {
    int R, C; stage_rc(tid * 16 + i * 8192, R, C);
    oa[i] = (unsigned)(R * (int)g.lda + C);
    ob[i] = (unsigned)(R * g.K + C);
  }
  f32x4 acc[2][2][4][2];
  gemm_kloop(g.A + brow * g.lda, g.A + (brow + 128) * g.lda, g.Bt + (long)bcol * g.K, g.Bt + (long)(bcol + 128) * g.K, oa, ob, g.K / 64, smem, acc, tid);
  __syncthreads();
  asm volatile("" : "+v"(tid));
  const int wid = tid >> 6, lane = tid & 63, wr = wid >> 2, wc = wid & 3, fr = lane & 15, fq = lane >> 4;
  float* aux = (float*)(smem + 256 * TS * 2);

  if (EPI == EPI_IN || EPI == EPI_UP) {
    float rs[2][4];
#pragma unroll
    for (int ai = 0; ai < 2; ++ai)
#pragma unroll
      for (int m = 0; m < 4; ++m) {
        long gr = brow + ai * 128 + wr * 64 + m * 16 + fr;
        gr = gr < 0 ? 0 : (gr > M_ - 1 ? M_ - 1 : gr);
        float4 s4 = *(const float4*)(g.rss + gr * 4);
        rs[ai][m] = rsqrtf((s4.x + s4.y + s4.z + s4.w) * (1.f / 1024.f) + EPS);
      }
#pragma unroll
    for (int ai = 0; ai < 2; ++ai) for (int bj = 0; bj < 2; ++bj) for (int m = 0; m < 4; ++m) for (int n = 0; n < 2; ++n) {
      int row = ai * 128 + wr * 64 + m * 16 + fr, col = bj * 128 + wc * 32 + n * 16 + fq * 4;
      f32x4 a = acc[ai][bj][m][n]; float s = rs[ai][m];
      h4 v; v[0] = (half_t)(a[0] * s); v[1] = (half_t)(a[1] * s); v[2] = (half_t)(a[2] * s); v[3] = (half_t)(a[3] * s);
      *(h4*)(smem + (row * TS + col) * 2) = v;
    }
    __syncthreads();
    if (EPI == EPI_IN) {
      if (pn <= 1 || (pn >= 4 && pn <= 6)) {
        half_t* tl = (half_t*)smem;
        const int sub = tid & 7;
        const int bb = (int)(brow >> 12), t0 = (int)(brow & (T_ - 1));
        const int nu = (pn <= 1) ? 4 : 2;
        const float* gain = (pn <= 1) ? g.qg : (pn == 5 ? g.kg1 : (pn == 6 ? g.kg2 : nullptr));
        const float scale = (pn <= 1) ? 0.125f * 1.4426950408889634f : 1.f;
        float gn8[8];
#pragma unroll
        for (int i = 0; i < 8; ++i) gn8[i] = gain ? gain[sub * 8 + i] : 1.f;
#pragma unroll 1
        for (int it = 0; it < 4; ++it) {
          const int row = (tid >> 3) + 64 * it; const long m = brow + row;
          float c8[8], s8[8];
#pragma unroll
          for (int i = 0; i < 8; ++i) { c8[i] = 1.f; s8[i] = 0.f; }
          if (sub < 2) {
#pragma unroll
            for (int i = 0; i < 8; ++i) { c8[i] = g.cs[m * 8 + i]; s8[i] = g.sn[m * 8 + i]; }
          }
#pragma unroll 1
          for (int u = 0; u < nu; ++u) {
            half_t* src = tl + row * TS + u * 64 + sub * 8;
            h8 v = *(const h8*)src; float f[8]; float ss = 0.f;
#pragma unroll
            for (int i = 0; i < 8; ++i) { f[i] = (float)v[i]; ss += f[i] * f[i]; }
            ss += __shfl_xor(ss, 1); ss += __shfl_xor(ss, 2); ss += __shfl_xor(ss, 4);
            if (gain) {
              float r = rsqrtf(ss * (1.f / 64.f) + EPS);
#pragma unroll
              for (int i = 0; i < 8; ++i) f[i] = f[i] * r * gn8[i];
            }
            h8 w;
#pragma unroll
            for (int i = 0; i < 8; ++i) {
              float other = __shfl_xor(f[i], 1);
              float o = f[i];
              if (sub == 0) o = f[i] * c8[i] - other * s8[i];
              else if (sub == 1) o = f[i] * c8[i] + other * s8[i];
              w[i] = (half_t)(o * scale);
            }
            *(h8*)src = w;
            if (pn == 4) *(h8*)(g.kcr + ((size_t)(bb * 2 + u) * T_ + t0 + row) * 64 + sub * 8) = w;
          }
        }
        if (pn == 5) __syncthreads();
        if (pn == 4) {
#pragma unroll
          for (int e = 0; e < 8; ++e) {
            int id = tid + NTH * e; int row = id >> 4, gg = (id >> 3) & 1, c8i = id & 7;
            *(h8*)(g.vcr + ((size_t)(bb * 2 + gg) * T_ + t0 + row) * 64 + c8i * 8) = *(const h8*)(tl + row * TS + 128 + gg * 64 + c8i * 8);
          }
        } else if (pn >= 5) {
          if (pn == 5) {
            const int krow = tid >> 3, kc8 = tid & 7;
#pragma unroll 1
            for (int q = 0; q < 8; ++q) {
              int kb = q >> 1, gg = q & 1;
              *(h8*)(g.kst + ((size_t)((bb * 2 + gg) * 64 + (t0 >> 6) + kb)) * 4096 + krow * 64 + kc8 * 8) = *(const h8*)(tl + (kb * 64 + krow) * TS + gg * 64 + kc8 * 8);
            }
          }
          half_t* vdst = (pn == 5) ? g.vst : g.vwt;
          const int d = tid >> 3, kc = tid & 7;
#pragma unroll 1
          for (int q = 0; q < 8; ++q) {
            int kb = q >> 1, gg = q & 1; h8 v;
#pragma unroll
            for (int i = 0; i < 8; ++i) v[i] = tl[(kb * 64 + kc * 8 + i) * TS + 128 + gg * 64 + d];
            *(h8*)(vdst + ((size_t)((bb * 2 + gg) * 64 + (t0 >> 6) + kb)) * 4096 + d * 64 + kc * 8) = v;
          }
        }
        __syncthreads();
      }
      tile_copy_out(smem, g.outh, g.ldo, brow, bcol, tid);
    } else {
      const int cgp = tid & 15;
      const int gc = pn * 128 + cgp * 8;
      float wg[3][8], wu[3][8], bg[8], bu[8];
#pragma unroll
      for (int j = 0; j < 3; ++j)
#pragma unroll
        for (int e = 0; e < 8; ++e) { wg[j][e] = g.convw[j * 5632 + gc + e]; wu[j][e] = g.convw[j * 5632 + 2816 + gc + e]; }
#pragma unroll
      for (int e = 0; e < 8; ++e) { bg[e] = g.convb[gc + e]; bu[e] = g.convb[2816 + gc + e]; }
      if (tid < 128) {
        int sel = tid >> 5, ch = tid & 31; int lr = sel < 2 ? sel : 252 + sel;
        half_t* dst = (sel < 2 ? g.hf : g.hl) + ((size_t)pm * 2 + (sel & 1)) * 5632 + pn * 256 + ch * 8;
        *(h8*)dst = *(const h8*)(smem + (lr * TS + ch * 8) * 2);
      }
      const bool seq_start = ((brow & (T_ - 1)) == 0);
#pragma unroll 1
      for (int e8 = 0; e8 < 8; ++e8) {
        int id = tid + NTH * e8; int lr = id >> 4;
        long gr = brow + lr;
        if (lr >= 2 || seq_start) {
          int t = (int)(gr & (T_ - 1));
          float m1 = t >= 1 ? 1.f : 0.f, m2 = t >= 2 ? 1.f : 0.f;
          const int lr1 = lr >= 1 ? lr - 1 : 0, lr2 = lr >= 2 ? lr - 2 : 0;
          h8 g0 = *(const h8*)(smem + (lr * TS + cgp * 8) * 2), g1 = *(const h8*)(smem + (lr1 * TS + cgp * 8) * 2), g2 = *(const h8*)(smem + (lr2 * TS + cgp * 8) * 2);
          h8 u0 = *(const h8*)(smem + (lr * TS + 128 + cgp * 8) * 2), u1 = *(const h8*)(smem + (lr1 * TS + 128 + cgp * 8) * 2), u2 = *(const h8*)(smem + (lr2 * TS + 128 + cgp * 8) * 2);
          h8 o;
#pragma unroll
          for (int e = 0; e < 8; ++e) {
            float yg = wg[2][e] * (float)g0[e] + m1 * wg[1][e] * (float)g1[e] + m2 * wg[0][e] * (float)g2[e] + bg[e];
            float yu = wu[2][e] * (float)u0[e] + m1 * wu[1][e] * (float)u1[e] + m2 * wu[0][e] * (float)u2[e] + bu[e];
            o[e] = (half_t)(silu_fast(yg) * yu);
          }
          *(h8*)(g.outh + gr * NFF + gc) = o;
        }
      }
    }
  } else if (EPI == EPI_RES) {
    float* S = (float*)smem;
#pragma unroll 1
    for (int ai = 0; ai < 2; ++ai) {
#pragma unroll
      for (int bj = 0; bj < 2; ++bj) for (int m = 0; m < 4; ++m) for (int n = 0; n < 2; ++n) {
        int row = wr * 64 + m * 16 + fr, col = bj * 128 + wc * 32 + n * 16 + fq * 4;
        f32x4 a = ai ? acc[1][bj][m][n] : acc[0][bj][m][n];
        *(f32x4*)(S + row * 260 + col) = a;
      }
      __syncthreads();
      {
        const long grow0 = brow + ai * 128 + wid * 16;
        h4 rv[16];
#pragma unroll
        for (int rr = 0; rr < 16; ++rr) rv[rr] = *(const h4*)(g.outh + (grow0 + rr) * g.ldo + bcol + lane * 4);
#pragma unroll
        for (int rr = 0; rr < 16; ++rr) {
          f32x4 a = *(const f32x4*)(S + (wid * 16 + rr) * 260 + lane * 4);
          float4 xn; xn.x = (float)rv[rr][0] + a[0]; xn.y = (float)rv[rr][1] + a[1]; xn.z = (float)rv[rr][2] + a[2]; xn.w = (float)rv[rr][3] + a[3];
          if (g.xout) {
            *(float4*)(g.xout + (grow0 + rr) * 1024 + bcol + lane * 4) = xn;
          } else {
            float ss = xn.x * xn.x + xn.y * xn.y + xn.z * xn.z + xn.w * xn.w;
#pragma unroll
            for (int o = 32; o >= 1; o >>= 1) ss += __shfl_xor(ss, o);
            if (lane == 0) g.rss_out[(grow0 + rr) * 4 + pn] = ss;
            h4 v; v[0] = (half_t)xn.x; v[1] = (half_t)xn.y; v[2] = (half_t)xn.z; v[3] = (half_t)xn.w;
            *(h4*)(g.outh + (grow0 + rr) * g.ldo + bcol + lane * 4) = v;
          }
        }
      }
      __syncthreads();
    }
  } else {
    if (tid < 256) { float s = 0.f; for (int kc = 0; kc < 16; ++kc) s += g.c1p[kc * 512 + tid]; aux[tid] = s; }
    __syncthreads();
#pragma unroll
    for (int ai = 0; ai < 2; ++ai) for (int bj = 0; bj < 2; ++bj) for (int m = 0; m < 4; ++m) for (int n = 0; n < 2; ++n) {
      int row = ai * 128 + wr * 64 + m * 16 + fr, col = bj * 128 + wc * 32 + n * 16 + fq * 4;
      f32x4 a = acc[ai][bj][m][n]; h4 v;
#pragma unroll
      for (int j = 0; j < 4; ++j) v[j] = (half_t)siluf(a[j] + aux[col + j]);
      *(h4*)(smem + (row * TS + col) * 2) = v;
    }
    __syncthreads();
    {
      const half_t* tl = (const half_t*)smem;
      const int l32 = lane & 31, hf = lane >> 5;
      f32x16 a2[2];
#pragma unroll
      for (int mt = 0; mt < 2; ++mt)
#pragma unroll
        for (int i = 0; i < 16; ++i) a2[mt][i] = 0.f;
#pragma unroll 4
      for (int s = 0; s < 16; ++s) {
        h8 b = *(const h8*)(tl + (32 * wid + l32) * TS + 16 * s + 8 * hf);
        h8 w0 = *(const h8*)(g.w2t + (l32) * 256 + 16 * s + 8 * hf);
        h8 w1 = *(const h8*)(g.w2t + (32 + l32) * 256 + 16 * s + 8 * hf);
        a2[0] = mfma32(w0, b, a2[0]); a2[1] = mfma32(w1, b, a2[1]);
      }
      const int ci = 32 * wid + l32; const int bgi = pm;
      if (g.kv == 0) {
        float ss = 0.f;
#pragma unroll
        for (int mt = 0; mt < 2; ++mt)
#pragma unroll
          for (int i = 0; i < 16; ++i) ss += a2[mt][i] * a2[mt][i];
        ss += __shfl_xor(ss, 32);
        float rr = rsqrtf(ss * (1.f / 64.f) + EPS);
#pragma unroll
        for (int mt = 0; mt < 2; ++mt)
#pragma unroll
          for (int r = 0; r < 4; ++r) {
            int d0 = 32 * mt + 8 * r + 4 * hf; h4 v;
#pragma unroll
            for (int i = 0; i < 4; ++i) v[i] = (half_t)(a2[mt][4 * r + i] * rr * g.kg0[d0 + i]);
            *(h4*)(g.kc + ((size_t)bgi * 256 + ci) * 64 + d0) = v;
          }
      } else {
#pragma unroll
        for (int mt = 0; mt < 2; ++mt)
#pragma unroll
          for (int rg = 0; rg < 16; ++rg) {
            int d = 32 * mt + crow(rg, hf);
            g.vct[((size_t)(bgi * 4 + (ci >> 6)) * 64 + d) * 64 + (ci & 63)] = (half_t)a2[mt][rg];
          }
      }
    }
  }
  __syncthreads();
}

DI void tile_decode(int t, int nM, int nN, int& pm, int& pn) {
  int per = 16 * nN; int sr = t / per; int rem = t - sr * per;
  int width = nM - sr * 16; if (width > 16) width = 16;
  pn = rem / width; pm = sr * 16 + rem % width;
}

template <int EPI>
__device__ void gemm_phase(const GArgs& g, char* smem) {
  int nt = g.nM * g.nN;
  for (int t = blockIdx.x; t < nt; t += gridDim.x) { int pm, pn; tile_decode(t, g.nM, g.nN, pm, pn); gemm_tile<EPI>(g, pm, pn, smem); }
}

__device__ void phase_prep(const Params& p, int l, char* smem) {
  char* ws = p.ws;
  half_t* proj = (half_t*)(ws + WS_PROJ);
  half_t* kcr = (half_t*)(ws + WS_KCR); half_t* vcr = (half_t*)(ws + WS_VCR);
  half_t* vst = (half_t*)(ws + WS_VST); half_t* vwt = (half_t*)(ws + WS_VWT);
  const float* cs = (const float*)(ws + WS_COS); const float* sn = (const float*)(ws + WS_SIN);
  const int tid = ltid();
  half_t* tl = (half_t*)smem;
  for (int it = blockIdx.x; it < 512; it += gridDim.x) {
    int b = it >> 6, blk = it & 63; long m0 = (long)b * T_ + blk * 64;
    {
      int tok = tid >> 3, sub = tid & 7; long m = m0 + tok; int t = blk * 64 + tok;
      float c8[8], s8[8];
      if (sub < 2) {
#pragma unroll
        for (int i = 0; i < 8; ++i) { c8[i] = cs[m * 8 + i]; s8[i] = sn[m * 8 + i]; }
      }
      h8 uv[14];
#pragma unroll
      for (int u = 0; u < 14; ++u) {
        int col = (u < 8) ? u * 64 : (u < 10 ? 1024 + (u - 8) * 64 : (u < 12 ? 1024 + 256 + (u - 10) * 64 : 1024 + 512 + (u - 12) * 64));
        uv[u] = *(const h8*)(proj + m * PL + col + sub * 8);
      }
      float gq[8], gs[8], gw[8];
#pragma unroll
      for (int i = 0; i < 8; ++i) { gq[i] = p.q_norm[l * 64 + sub * 8 + i]; gs[i] = p.k_norm[(l * 3 + 1) * 64 + sub * 8 + i]; gw[i] = p.k_norm[(l * 3 + 2) * 64 + sub * 8 + i]; }
#pragma unroll
      for (int u = 0; u < 14; ++u) {
        int col = (u < 8) ? u * 64 : (u < 10 ? 1024 + (u - 8) * 64 : (u < 12 ? 1024 + 256 + (u - 10) * 64 : 1024 + 512 + (u - 12) * 64));
        const bool norm = !(u == 8 || u == 9);
        const float scale = (u < 8) ? 0.125f * 1.4426950408889634f : 1.f;
        h8 v = uv[u]; float f[8]; float ss = 0.f;
#pragma unroll
        for (int i = 0; i < 8; ++i) { f[i] = (float)v[i]; ss += f[i] * f[i]; }
        if (norm) {
          ss += __shfl_xor(ss, 1); ss += __shfl_xor(ss, 2); ss += __shfl_xor(ss, 4);
          float r = rsqrtf(ss * (1.f / 64.f) + EPS);
#pragma unroll
          for (int i = 0; i < 8; ++i) f[i] = f[i] * r * (u < 8 ? gq[i] : (u < 12 ? gs[i] : gw[i]));
        }
        float o[8];
#pragma unroll
        for (int i = 0; i < 8; ++i) {
          float other = __shfl_xor(f[i], 1);
          o[i] = f[i];
          if (sub == 0) o[i] = f[i] * c8[i] - other * s8[i];
          else if (sub == 1) o[i] = f[i] * c8[i] + other * s8[i];
          o[i] *= scale;
        }
        h8 w;
#pragma unroll
        for (int i = 0; i < 8; ++i) w[i] = (half_t)o[i];
        if (u == 8 || u == 9) { int g = u - 8; *(h8*)(kcr + ((size_t)(b * 2 + g) * T_ + t) * 64 + sub * 8) = w; }
        else *(h8*)(proj + m * PL + col + sub * 8) = w;
      }
    }
#pragma unroll
    for (int e = 0; e < 2; ++e) {
      int id = tid + NTH * e; int tok = id >> 4, g = (id >> 3) & 1, c8i = id & 7;
      h8 v = *(const h8*)(proj + (m0 + tok) * PL + 1024 + 128 + g * 64 + c8i * 8);
      *(h8*)(vcr + ((size_t)(b * 2 + g) * T_ + blk * 64 + tok) * 64 + c8i * 8) = v;
    }
#pragma unroll 1
    for (int q = 0; q < 4; ++q) {
      int g = q & 1; int col = 1024 + (q < 2 ? 256 : 512) + 128 + g * 64;
      half_t* dst = (q < 2 ? vst : vwt) + ((size_t)((b * 2 + g) * 64 + blk)) * 4096;
      __syncthreads();
      { int tok = tid >> 3, c8i = tid & 7; h8 v = *(const h8*)(proj + (m0 + tok) * PL + col + c8i * 8);
#pragma unroll
        for (int i = 0; i < 8; ++i) tl[tok * 66 + c8i * 8 + i] = v[i]; }
      __syncthreads();
      { int d = tid >> 3, kc = tid & 7; h8 v;
#pragma unroll
        for (int i = 0; i < 8; ++i) v[i] = tl[(kc * 8 + i) * 66 + d];
        *(h8*)(dst + d * 64 + kc * 8) = v; }
    }
    __syncthreads();
  }
}

__device__ void gdn_pre_item(const Params& p, int l, int item, char* smem) {
  char* ws = p.ws;
  const half_t* proj = (const half_t*)(ws + WS_PROJ);
  half_t* WG = (half_t*)p.out; half_t* QG = WG + (size_t)M_ * 512; half_t* UG = QG + (size_t)M_ * 512;
  half_t* KTG = UG + (size_t)M_ * 512; half_t* AQK = (half_t*)(ws + WS_AQK); float* GL = (float*)(ws + WS_GL);
  int tid_ = threadIdx.x; asm volatile("" : "+v"(tid_));
  const int tid = tid_, wid = tid >> 6, lane = tid & 63;
  const int bh = item >> 6, n = item & 63, b = bh >> 2, h = bh & 3;
  const int cid = item; const long m0 = (long)b * T_ + n * 64;
  constexpr int RS = 392;
  half_t* raw = (half_t*)smem;
  float* Akk = (float*)smem; half_t* Th = (half_t*)(smem + 16384); half_t* KtT = (half_t*)(smem + 25600);
  float* TL = (float*)(smem + 44032);
  half_t* Kn = (half_t*)(smem + 61440);
  half_t* Qn = (half_t*)(smem + 78848);
  half_t* Vn = (half_t*)(smem + 96256);
  half_t* VbT = (half_t*)(smem + 113664);
  half_t* KbgT = (half_t*)(smem + 132096);
  float* gv = (float*)(smem + 150528);
  float* gcum = gv; float* beta = gv + 64;

  for (int id = tid; id < 67 * 48; id += NTH) {
    int rr = id / 48, ch = id % 48; int arr = ch >> 4, c8i = ch & 15;
    int t = n * 64 - 3 + rr;
    h8 v = {0, 0, 0, 0, 0, 0, 0, 0};
    if (t >= 0) v = *(const h8*)(proj + ((long)b * T_ + t) * PL + 1792 + arr * 512 + h * 128 + c8i * 8);
    *(h8*)(raw + rr * RS + arr * 128 + c8i * 8) = v;
  }
  if (wid == 0) {
    float a = (float)proj[(m0 + lane) * PL + 3352 + h], bb = (float)proj[(m0 + lane) * PL + 3356 + h];
    float xx = a + p.gdn_dt_bias[l * 4 + h];
    float ey = __expf(-fabsf(xx));
    float l1p = ey < 0.01f ? ey * (1.f - ey * (0.5f - ey * (1.f / 3.f))) : __logf(1.f + ey);
    float sp = fmaxf(xx, 0.f) + l1p;
    float gval = -expf(p.gdn_a_log[l * 4 + h]) * sp;
#pragma unroll
    for (int o = 1; o < 64; o <<= 1) { float y = __shfl_up(gval, o); if (lane >= o) gval += y; }
    gcum[lane] = gval; beta[lane] = sigm(bb);
  }
  __syncthreads();
  const int r = tid >> 3, sub = tid & 7;
  {
    const float* cw = p.gdn_conv_w + (size_t)l * 4 * 1536;
#pragma unroll 1
    for (int arr = 0; arr < 3; ++arr) {
      float y[16]; float ss = 0.f;
#pragma unroll
      for (int e2 = 0; e2 < 16; ++e2) y[e2] = 0.f;
#pragma unroll
      for (int j = 0; j < 4; ++j) {
        const half_t* xr = raw + (r + j) * RS + arr * 128 + sub * 16;
        h8 x0 = *(const h8*)xr, x1 = *(const h8*)(xr + 8);
        const float* wp = cw + j * 1536 + arr * 512 + h * 128 + sub * 16;
        float4 w0 = *(const float4*)wp, w1 = *(const float4*)(wp + 4), w2 = *(const float4*)(wp + 8), w3 = *(const float4*)(wp + 12);
        y[0] += w0.x * (float)x0[0]; y[1] += w0.y * (float)x0[1]; y[2] += w0.z * (float)x0[2]; y[3] += w0.w * (float)x0[3];
        y[4] += w1.x * (float)x0[4]; y[5] += w1.y * (float)x0[5]; y[6] += w1.z * (float)x0[6]; y[7] += w1.w * (float)x0[7];
        y[8] += w2.x * (float)x1[0]; y[9] += w2.y * (float)x1[1]; y[10] += w2.z * (float)x1[2]; y[11] += w2.w * (float)x1[3];
        y[12] += w3.x * (float)x1[4]; y[13] += w3.y * (float)x1[5]; y[14] += w3.z * (float)x1[6]; y[15] += w3.w * (float)x1[7];
      }
#pragma unroll
      for (int e2 = 0; e2 < 16; ++e2) { float a = silu_fast(y[e2]); y[e2] = a; ss += a * a; }
      ss += __shfl_xor(ss, 1); ss += __shfl_xor(ss, 2); ss += __shfl_xor(ss, 4);
      float sc = (arr == 0) ? rsqrtf(ss + EPS) * 0.08838834764831845f : (arr == 1 ? rsqrtf(ss + EPS) : 1.f);
      half_t* dst = (arr == 0) ? Qn : (arr == 1 ? Kn : Vn);
      h8 o0, o1;
#pragma unroll
      for (int e2 = 0; e2 < 8; ++e2) { o0[e2] = (half_t)(y[e2] * sc); o1[e2] = (half_t)(y[8 + e2] * sc); }
      *(h8*)(dst + r * 136 + sub * 16) = o0; *(h8*)(dst + r * 136 + sub * 16 + 8) = o1;
    }
  }
  __syncthreads();
  {
    float gc = gcum[r], bt = beta[r], gl = gcum[63];
    float eg = expf(gc), ek = expf(gl - gc);
    h8 q0, q1;
    h8 kv8[2], vv8[2], qv8[2];
    kv8[0] = *(const h8*)(Kn + r * 136 + sub * 16); kv8[1] = *(const h8*)(Kn + r * 136 + sub * 16 + 8);
    vv8[0] = *(const h8*)(Vn + r * 136 + sub * 16); vv8[1] = *(const h8*)(Vn + r * 136 + sub * 16 + 8);
    qv8[0] = *(const h8*)(Qn + r * 136 + sub * 16); qv8[1] = *(const h8*)(Qn + r * 136 + sub * 16 + 8);
#pragma unroll
    for (int e = 0; e < 16; ++e) {
      int d = sub * 16 + e;
      float kk = (float)kv8[e >> 3][e & 7], vv = (float)vv8[e >> 3][e & 7], qq = (float)qv8[e >> 3][e & 7];
      KbgT[d * 72 + r] = (half_t)(kk * bt * eg);
      VbT[d * 72 + r] = (half_t)(vv * bt);
      KtT[d * 72 + r] = (half_t)(kk * ek);
      half_t qv = (half_t)(qq * eg);
      if (e < 8) q0[e] = qv; else q1[e - 8] = qv;
    }
    *(h8*)(QG + (m0 + r) * 512 + h * 128 + sub * 16) = q0;
    *(h8*)(QG + (m0 + r) * 512 + h * 128 + sub * 16 + 8) = q1;
    if (tid == 0) GL[cid] = expf(gl);
  }
  __syncthreads();
  {
    const int which = wid >> 2, ti = (wid >> 1) & 1, tj = wid & 1, l32 = lane & 31, hf = lane >> 5;
    const half_t* Am = which ? Qn : Kn;
    f32x16 acc;
#pragma unroll
    for (int i = 0; i < 16; ++i) acc[i] = 0.f;
#pragma unroll
    for (int s = 0; s < 8; ++s) {
      h8 a = *(const h8*)(Am + (32 * ti + l32) * 136 + 16 * s + 8 * hf);
      h8 bb = *(const h8*)(Kn + (32 * tj + l32) * 136 + 16 * s + 8 * hf);
      acc = mfma32(a, bb, acc);
    }
    int j = 32 * tj + l32; float gj = gcum[j];
#pragma unroll
    for (int rg = 0; rg < 16; ++rg) {
      int i = 32 * ti + crow(rg, hf); float gi = gcum[i];
      if (which == 0) { float v = (j < i) ? beta[i] * acc[rg] * expf(gi - gj) : 0.f; Akk[i * 64 + j] = v; }
      else { float v = (j <= i) ? acc[rg] * expf(gi - gj) : 0.f; AQK[(size_t)cid * 4096 + i * 64 + j] = (half_t)v; }
    }
#pragma unroll
    for (int e = 0; e < 2; ++e) { int id = tid + NTH * e; int row = id >> 3, c8i = id & 7;
      *(h8*)(KTG + (size_t)cid * 8192 + row * 64 + c8i * 8) = *(const h8*)(KtT + row * 72 + c8i * 8); }
  }
  __syncthreads();
  float* Dg = TL + 64 * 65;
  float* RB = Dg + 1024;
  if (wid == 0) {
    const int blk = lane >> 4, cc = lane & 15;
    float x[16];
#pragma unroll
    for (int ii = 0; ii < 16; ++ii) {
      const float* ar = Akk + (16 * blk + ii) * 64 + 16 * blk;
      f32x4 a0 = *(const f32x4*)ar, a1 = *(const f32x4*)(ar + 4), a2 = *(const f32x4*)(ar + 8), a3 = *(const f32x4*)(ar + 12);
      float av[16] = {a0[0], a0[1], a0[2], a0[3], a1[0], a1[1], a1[2], a1[3], a2[0], a2[1], a2[2], a2[3], a3[0], a3[1], a3[2], a3[3]};
      float a = (ii == cc) ? 1.f : 0.f;
#pragma unroll
      for (int jj = 0; jj < ii; ++jj) a -= av[jj] * x[jj];
      x[ii] = a;
    }
#pragma unroll
    for (int ii = 0; ii < 16; ++ii) Dg[(blk * 16 + ii) * 16 + cc] = x[ii];
  }
  __syncthreads();
#pragma unroll 1
  for (int I = 0; I < 4; ++I) {
    const int il = tid >> 5, c0 = (tid & 31) * 2; const int i = 16 * I + il;
    {
      float a0 = (i == c0) ? 1.f : 0.f, a1 = (i == c0 + 1) ? 1.f : 0.f;
      for (int j = 0; j < 16 * I; ++j) { float av = Akk[i * 64 + j]; a0 -= av * TL[j * 65 + c0]; a1 -= av * TL[j * 65 + c0 + 1]; }
      RB[il * 65 + c0] = a0; RB[il * 65 + c0 + 1] = a1;
    }
    __syncthreads();
    {
      float t0 = 0.f, t1 = 0.f;
#pragma unroll
      for (int k = 0; k < 16; ++k) { float dv = Dg[(I * 16 + il) * 16 + k]; t0 += dv * RB[k * 65 + c0]; t1 += dv * RB[k * 65 + c0 + 1]; }
      TL[i * 65 + c0] = t0; TL[i * 65 + c0 + 1] = t1;
      Th[i * 72 + c0] = (half_t)t0; Th[i * 72 + c0 + 1] = (half_t)t1;
    }
    __syncthreads();
  }
  {
    const int ti = wid >> 2, tj = wid & 3, l32 = lane & 31, hf = lane >> 5;
    f32x16 au, aw;
#pragma unroll
    for (int i = 0; i < 16; ++i) { au[i] = 0.f; aw[i] = 0.f; }
#pragma unroll
    for (int s = 0; s < 4; ++s) {
      h8 a = *(const h8*)(Th + (32 * ti + l32) * 72 + 16 * s + 8 * hf);
      h8 bu = *(const h8*)(VbT + (32 * tj + l32) * 72 + 16 * s + 8 * hf);
      h8 bw = *(const h8*)(KbgT + (32 * tj + l32) * 72 + 16 * s + 8 * hf);
      au = mfma32(a, bu, au); aw = mfma32(a, bw, aw);
    }
#pragma unroll
    for (int rg = 0; rg < 16; ++rg) {
      int i = 32 * ti + crow(rg, hf); int dv = 32 * tj + l32;
      UG[(m0 + i) * 512 + h * 128 + dv] = (half_t)au[rg];
      WG[(m0 + i) * 512 + h * 128 + dv] = (half_t)aw[rg];
    }
  }
  __syncthreads();
}

__device__ void phase_cmp2(const Params& p, int l, char* smem) {
  char* ws = p.ws;
  const half_t* hid = (const half_t*)(ws + WS_HID);
  half_t* KC = (half_t*)(ws + WS_KC); half_t* VCT = (half_t*)(ws + WS_VCT);
  const int tid = ltid();
  half_t* hl = (half_t*)smem;
  float* w2 = (float*)(smem + 64 * 264 * 2);
  for (int it = blockIdx.x; it < 128; it += gridDim.x) {
    int kv = it >> 6, bg = (it >> 2) & 15, Tt = it & 3;
    const half_t* src = hid + ((size_t)kv * 4096 + bg * 256 + Tt * 64) * 256;
#pragma unroll
    for (int e = 0; e < 4; ++e) { int id = tid + NTH * e; int row = id >> 5, c16 = id & 31; *(h8*)(hl + row * 264 + c16 * 8) = *(const h8*)(src + row * 256 + c16 * 8); }
    const float* w2g = p.cmp_w2 + (size_t)(l * 2 + kv) * 256 * 64;
#pragma unroll
    for (int e = 0; e < 8; ++e) { int id = tid + NTH * e; *(float4*)(w2 + id * 4) = *(const float4*)(w2g + id * 4); }
    __syncthreads();
    int r = tid >> 3, dg = tid & 7; float acc[8];
#pragma unroll
    for (int i = 0; i < 8; ++i) acc[i] = 0.f;
    for (int k = 0; k < 256; ++k) {
      float hv = (float)hl[r * 264 + k];
      float4 wa = *(const float4*)(w2 + k * 64 + dg * 8), wb = *(const float4*)(w2 + k * 64 + dg * 8 + 4);
      acc[0] += hv * wa.x; acc[1] += hv * wa.y; acc[2] += hv * wa.z; acc[3] += hv * wa.w;
      acc[4] += hv * wb.x; acc[5] += hv * wb.y; acc[6] += hv * wb.z; acc[7] += hv * wb.w;
    }
    if (kv == 0) {
      float ss = 0.f;
#pragma unroll
      for (int i = 0; i < 8; ++i) ss += acc[i] * acc[i];
      ss += __shfl_xor(ss, 1); ss += __shfl_xor(ss, 2); ss += __shfl_xor(ss, 4);
      float rr = rsqrtf(ss * (1.f / 64.f) + EPS);
      h8 v;
#pragma unroll
      for (int i = 0; i < 8; ++i) v[i] = (half_t)(acc[i] * rr * p.k_norm[(l * 3 + 0) * 64 + dg * 8 + i]);
      *(h8*)(KC + ((size_t)bg * 256 + Tt * 64 + r) * 64 + dg * 8) = v;
    } else {
#pragma unroll
      for (int i = 0; i < 8; ++i) VCT[((size_t)(bg * 4 + Tt) * 64 + dg * 8 + i) * 64 + r] = (half_t)acc[i];
    }
    __syncthreads();
  }
}

constexpr int KVS = 72;
struct NsaCtx {
  const half_t* proj; const half_t* KC; const half_t* VCT; const half_t* VST; const half_t* VWT; const half_t* KST;
  int b, g, qb, bg; int tq; int l32, hf; int tid;
};

template <int MODE>
DI void nsa_branch(const NsaCtx& c, char* smem, int& bufsel, const h8 (&qf)[4], const float shift, float& l_run, f32x16 (&ot)[2],
                   float (&imp)[32], const unsigned* selmask_q, const unsigned* unionmask) {
  const int tid = c.tid;
  const int l32 = c.l32, hf = c.hf;
  const int ql = c.tq & 63;
  int cilim = (c.tq - 31) >> 4; if (cilim > 254) cilim = 254;
  unsigned um0 = 0, um1 = 0, sm0 = 0, sm1 = 0;
  if (MODE == 2) { um0 = unionmask[0]; um1 = unionmask[1]; sm0 = selmask_q[0]; sm1 = selmask_q[1]; }
  int jlo, jhi;
  if (MODE <= 1) { int cnt = 4 * c.qb + 3; if (cnt > 255) cnt = 255; jlo = 0; jhi = (cnt + 63) / 64 - 1; }
  else if (MODE == 2) { jlo = 0; jhi = c.qb; }
  else { jlo = c.qb - 8 < 0 ? 0 : c.qb - 8; jhi = c.qb; }
  auto next_tile = [&](int j) -> int {
    ++j;
    if (MODE == 2) { while (j <= jhi && !(((j < 32 ? um0 >> j : um1 >> (j - 32)) & 1u))) ++j; }
    return j <= jhi ? j : -1;
  };
  h8 kreg[2], vreg[2];
  auto load_regs = [&](int j, h8& kr, h8& vr) {
    int row = tid >> 3, c8i = tid & 7;
    if (MODE <= 1) {
      kr = *(const h8*)(c.KC + ((size_t)c.bg * 256 + j * 64 + row) * 64 + c8i * 8);
      if (MODE == 1) vr = *(const h8*)(c.VCT + (size_t)(c.bg * 4 + j) * 4096 + tid * 8);
    } else {
      int col = 1024 + (MODE == 2 ? 256 : 512) + c.g * 64;
      if (MODE == 2) kr = *(const h8*)(c.KST + (size_t)(c.bg * 64 + j) * 4096 + tid * 8);
      else kr = *(const h8*)(c.proj + ((size_t)c.b * T_ + j * 64 + row) * PL + col + c8i * 8);
      vr = *(const h8*)((MODE == 2 ? c.VST : c.VWT) + (size_t)(c.bg * 64 + j) * 4096 + tid * 8);
    }
  };
  float ylast = 0.f;
  auto compute = [&](int j, const half_t* K, const half_t* V) {
    bool selj = true;
    if (MODE == 2) selj = ((j < 32 ? sm0 >> j : sm1 >> (j - 32)) & 1u) != 0;
    const float init = selj ? -shift : -INFINITY;
    bool need_mask; int lim = 63, lo = 0;
    if (MODE <= 1) { need_mask = true; lim = cilim - 64 * j; }
    else if (MODE == 2) { need_mask = (j == c.qb); lim = ql; }
    else { need_mask = (j == c.qb) || (j == c.qb - 8); if (j == c.qb) lim = ql; else lo = ql + 1; }
    float ps = 0.f;
#pragma unroll
    for (int kt = 0; kt < 2; ++kt) {
      f32x16 st;
      {
        h8 kf[4];
#pragma unroll
        for (int s = 0; s < 4; ++s) kf[s] = *(const h8*)(K + (32 * kt + l32) * KVS + 16 * s + 8 * hf);
#pragma unroll
        for (int i = 0; i < 16; ++i) st[i] = init;
#pragma unroll
        for (int s = 0; s < 4; ++s) st = mfma32(kf[s], qf[s], st);
        __builtin_amdgcn_sched_group_barrier(0x100, 4, 0);
        __builtin_amdgcn_sched_group_barrier(0x008, 4, 0);
      }
      if (need_mask) {
        asm volatile("; boundary tile mask" ::: );
#pragma unroll
        for (int rg = 0; rg < 16; ++rg) {
          int key = 32 * kt + crow(rg, hf);
          st[rg] = (key <= lim && key >= lo) ? st[rg] : -INFINITY;
        }
      }
#pragma unroll
      for (int rg = 0; rg < 16; ++rg) { float pv = EXP2(st[rg]); st[rg] = pv; ps += pv; }
      if (MODE == 1) {
        float y[4];
#pragma unroll
        for (int r = 0; r < 4; ++r) y[r] = __shfl_xor(st[4 * r + 3], 32);
#pragma unroll
        for (int r = 0; r < 4; ++r) {
          float own = st[4 * r] + st[4 * r + 1] + st[4 * r + 2] + st[4 * r + 3];
          float prev = (r > 0) ? y[r - 1] : ylast;
          float carry = hf ? y[r] : prev;
          float add = own + carry;
#pragma unroll
          for (int Tt = 0; Tt < 4; ++Tt) imp[Tt * 8 + kt * 4 + r] += (j == Tt) ? add : 0.f;
        }
        ylast = y[3];
      }
      h8 pf[2];
#pragma unroll
      for (int s2 = 0; s2 < 2; ++s2)
#pragma unroll
        for (int i2 = 0; i2 < 4; ++i2) {
          h2 pr = __builtin_bit_cast(h2, __builtin_amdgcn_cvt_pkrtz(st[8 * s2 + 2 * i2], st[8 * s2 + 2 * i2 + 1]));
          pf[s2][2 * i2] = pr[0]; pf[s2][2 * i2 + 1] = pr[1];
        }
      {
        h8 vf[2][2];
#pragma unroll
        for (int dt = 0; dt < 2; ++dt)
#pragma unroll
          for (int s2 = 0; s2 < 2; ++s2) {
            h4 v0 = *(const h4*)(V + (32 * dt + l32) * KVS + 32 * kt + 16 * s2 + 4 * hf);
            h4 v1 = *(const h4*)(V + (32 * dt + l32) * KVS + 32 * kt + 16 * s2 + 8 + 4 * hf);
            vf[dt][s2] = cat44(v0, v1);
          }
#pragma unroll
        for (int s2 = 0; s2 < 2; ++s2)
#pragma unroll
          for (int dt = 0; dt < 2; ++dt) ot[dt] = mfma32(vf[dt][s2], pf[s2], ot[dt]);
      }
    }
    l_run += ps;
  };
  int ja = next_tile(jlo - 1);
  int jb = ja >= 0 ? next_tile(ja) : -1;
  if (ja >= 0) load_regs(ja, kreg[0], vreg[0]);
  if (jb >= 0) load_regs(jb, kreg[1], vreg[1]);
  while (ja >= 0) {
    char* sb = smem + bufsel * 36864;
    { int row = tid >> 3, c8i = tid & 7;
      *(h8*)((half_t*)(sb) + row * KVS + c8i * 8) = kreg[0];
      if (MODE != 0) *(h8*)((half_t*)(sb + 18432) + row * KVS + c8i * 8) = vreg[0];
      if (jb >= 0) {
        *(h8*)((half_t*)(sb + 9216) + row * KVS + c8i * 8) = kreg[1];
        if (MODE != 0) *(h8*)((half_t*)(sb + 27648) + row * KVS + c8i * 8) = vreg[1];
      } }
    __syncthreads();
    int jc = jb >= 0 ? next_tile(jb) : -1;
    int jd = jc >= 0 ? next_tile(jc) : -1;
    if (jc >= 0) load_regs(jc, kreg[0], vreg[0]);
    if (jd >= 0) load_regs(jd, kreg[1], vreg[1]);
    compute(ja, (const half_t*)sb, (const half_t*)(sb + 18432));
    if (jb >= 0) compute(jb, (const half_t*)(sb + 9216), (const half_t*)(sb + 27648));
    bufsel ^= 1; ja = jc; jb = jd;
  }
}

__device__ void nsa_item(const Params& p, int l, int item, char* smem, int dry = 0) {
  char* ws = p.ws;
  half_t* proj = (half_t*)(ws + WS_PROJ);
  int tid_ = threadIdx.x; asm volatile("" : "+v"(tid_));
  const int tid = tid_, wid = tid >> 6, lane = tid & 63;
  NsaCtx c; c.tid = tid;
  c.proj = proj; c.KC = (const half_t*)(ws + WS_KC); c.VCT = (const half_t*)(ws + WS_VCT);
  c.VST = (const half_t*)(ws + WS_VST); c.VWT = (const half_t*)(ws + WS_VWT); c.KST = (const half_t*)(ws + WS_KST);
  c.qb = 63 - (item >> 4); c.bg = item & 15; c.b = c.bg >> 1; c.g = c.bg & 1;
  c.l32 = lane & 31; c.hf = lane >> 5;
  const int hp = wid >> 1, qhalf = wid & 1, h = c.g * 4 + hp;
  const int ql = 32 * qhalf + c.l32;
  c.tq = c.qb * 64 + ql;
  const long mq = (long)c.b * T_ + c.tq;
  float* impbuf = (float*)(smem + 73728);
  float* seltot = (float*)(smem + 73728 + 65536);
  unsigned* selmask = (unsigned*)(smem + 73728 + 65536 + 16384);
  unsigned* unionmask = selmask + 128;
  h8 qf[4];
#pragma unroll
  for (int s = 0; s < 4; ++s) qf[s] = *(const h8*)(proj + mq * PL + h * 64 + 16 * s + 8 * c.hf);
  float gate[3];
#pragma unroll
  for (int br = 0; br < 3; ++br) gate[br] = sigm((float)proj[mq * PL + 3328 + h * 3 + br]);
  f32x16 outacc[2], ot[2];
#pragma unroll
  for (int dt = 0; dt < 2; ++dt)
#pragma unroll
    for (int i = 0; i < 16; ++i) { outacc[dt][i] = 0.f; ot[dt][i] = 0.f; }
  float imp[32];
#pragma unroll
  for (int i = 0; i < 32; ++i) imp[i] = 0.f;
  int bufsel = 0;
  if (tid < 130) selmask[tid] = 0u;
  float shiftv[3];
  {
    float gq = fabsf(p.q_norm[l * 64 + lane]);
    float g0 = fabsf(p.k_norm[(l * 3 + 0) * 64 + lane]), g1 = fabsf(p.k_norm[(l * 3 + 1) * 64 + lane]), g2 = fabsf(p.k_norm[(l * 3 + 2) * 64 + lane]);
#pragma unroll
    for (int o = 32; o >= 1; o >>= 1) { gq = fmaxf(gq, __shfl_xor(gq, o)); g0 = fmaxf(g0, __shfl_xor(g0, o)); g1 = fmaxf(g1, __shfl_xor(g1, o)); g2 = fmaxf(g2, __shfl_xor(g2, o)); }
    shiftv[0] = fmaxf(0.f, 11.5416f * gq * g0 - 14.f); shiftv[1] = fmaxf(0.f, 11.5416f * gq * g1 - 14.f); shiftv[2] = fmaxf(0.f, 11.5416f * gq * g2 - 14.f);
  }
  float l_run = 0.f;
  nsa_branch<1>(c, smem, bufsel, qf, shiftv[0], l_run, ot, imp, nullptr, nullptr);
  { float lt = l_run + __shfl_xor(l_run, 32); float inv = lt > 0.f ? 1.f / lt : 0.f;
#pragma unroll
    for (int dt = 0; dt < 2; ++dt)
#pragma unroll
      for (int i = 0; i < 16; ++i) { outacc[dt][i] += gate[0] * inv * ot[dt][i]; ot[dt][i] = 0.f; }
#pragma unroll
    for (int i = 0; i < 32; ++i) {
      int Tt = i >> 3, kt = (i >> 2) & 1, r = i & 3;
      impbuf[(hp * 64 + ql) * 64 + 16 * Tt + 8 * kt + 2 * r + c.hf] = imp[i] * inv;
    } }
  __syncthreads();
  {
    int q = tid >> 3, sub = tid & 7; int cur = c.qb;
#pragma unroll
    for (int k = 0; k < 8; ++k) {
      int j = sub + 8 * k;
      float v = impbuf[(0 * 64 + q) * 64 + j] + impbuf[(1 * 64 + q) * 64 + j] + impbuf[(2 * 64 + q) * 64 + j] + impbuf[(3 * 64 + q) * 64 + j];
      if (j == 0 || j == cur || j == cur - 1) v = INFINITY;
      else if (j > cur) v = -INFINITY;
      seltot[q * 64 + j] = v;
    }
  }
  __syncthreads();
  {
    int q = tid >> 3, sub = tid & 7;
    float mine[8]; int rank[8];
#pragma unroll
    for (int k = 0; k < 8; ++k) { mine[k] = seltot[q * 64 + sub + 8 * k]; rank[k] = 0; }
    for (int jj = 0; jj < 64; ++jj) {
      float o = seltot[q * 64 + jj];
#pragma unroll
      for (int k = 0; k < 8; ++k) { int j = sub + 8 * k; rank[k] += (o > mine[k] || (o == mine[k] && jj < j)) ? 1 : 0; }
    }
    unsigned b0 = 0, b1 = 0;
#pragma unroll
    for (int k = 0; k < 8; ++k) { int j = sub + 8 * k; if (rank[k] < 16) { if (j < 32) b0 |= 1u << j; else b1 |= 1u << (j - 32); } }
    if (b0) { atomicOr(&selmask[q * 2], b0); atomicOr(&unionmask[0], b0); }
    if (b1) { atomicOr(&selmask[q * 2 + 1], b1); atomicOr(&unionmask[1], b1); }
  }
  __syncthreads();
  l_run = 0.f;
  nsa_branch<2>(c, smem, bufsel, qf, shiftv[1], l_run, ot, imp, selmask + ql * 2, unionmask);
  { float lt = l_run + __shfl_xor(l_run, 32); float inv = lt > 0.f ? 1.f / lt : 0.f;
#pragma unroll
    for (int dt = 0; dt < 2; ++dt)
#pragma unroll
      for (int i = 0; i < 16; ++i) { outacc[dt][i] += gate[1] * inv * ot[dt][i]; ot[dt][i] = 0.f; } }
  l_run = 0.f;
  nsa_branch<3>(c, smem, bufsel, qf, shiftv[2], l_run, ot, imp, nullptr, nullptr);
  { float lt = l_run + __shfl_xor(l_run, 32); float inv = lt > 0.f ? 1.f / lt : 0.f;
#pragma unroll
    for (int dt = 0; dt < 2; ++dt)
#pragma unroll
      for (int i = 0; i < 16; ++i) outacc[dt][i] += gate[2] * inv * ot[dt][i]; }
  float ss = 0.f;
#pragma unroll
  for (int dt = 0; dt < 2; ++dt)
#pragma unroll
    for (int i = 0; i < 16; ++i) ss += outacc[dt][i] * outacc[dt][i];
  ss += __shfl_xor(ss, 32);
  float rr = rsqrtf(ss * (1.f / 64.f) + EPS);
  int t2 = tid; asm volatile("" : "+v"(t2));
  const int h2 = c.g * 4 + (t2 >> 7);
  const long mq2 = (long)c.b * T_ + c.qb * 64 + 32 * ((t2 >> 6) & 1) + (t2 & 31);
  const float* og = p.nsa_out_norm + (size_t)(l * 8 + h2) * 64;
#pragma unroll
  for (int dt = 0; dt < 2; ++dt)
#pragma unroll
    for (int r = 0; r < 4; ++r) {
      int d0 = 32 * dt + 8 * r + 4 * c.hf; h4 v;
#pragma unroll
      for (int i = 0; i < 4; ++i) v[i] = (half_t)(outacc[dt][4 * r + i] * rr * og[d0 + i]);
      *(h4*)(proj + mq2 * PL + (dry ? 2304 : 0) + h2 * 64 + d0) = v;
    }
  __syncthreads();
}

__device__ void gdn_scan_item(const Params& p, int l, int bh, char* smem, int dry = 0) {
  char* ws = p.ws;
  half_t* proj = (half_t*)(ws + WS_PROJ);
  const half_t* WG = (const half_t*)p.out; const half_t* QG = WG + (size_t)M_ * 512; const half_t* UG = QG + (size_t)M_ * 512;
  const half_t* KTG = UG + (size_t)M_ * 512; const half_t* AQK = (const half_t*)(ws + WS_AQK); const float* GL = (const float*)(ws + WS_GL);
  int tid_ = threadIdx.x; asm volatile("" : "+v"(tid_));
  const int tid = tid_, wid = tid >> 6, lane = tid & 63, l16 = lane & 15, quad = lane >> 4;
  const int b = bh >> 2, h = bh & 3;
  half_t* Wl = (half_t*)smem;
  half_t* Ql = (half_t*)(smem + 17408);
  half_t* Al = (half_t*)(smem + 34816);
  half_t* Ktl = (half_t*)(smem + 44032);
  half_t* Ul = (half_t*)(smem + 62464);
  float* ost = (float*)(smem + 79872);
  f32x4 St[8];
#pragma unroll
  for (int i = 0; i < 8; ++i) St[i] = f32x4{0.f, 0.f, 0.f, 0.f};
  h8 rw[2], rq[2], ru[2], rk[2], ra, rz[2], zc[2];
  auto prefetch = [&](int n) {
    long m0 = (long)b * T_ + n * 64; size_t cid = (size_t)bh * 64 + n;
    { const half_t* zp0 = proj + (m0 + (tid >> 3)) * PL + 512 + h * 128 + (tid & 7) * 16; rz[0] = *(const h8*)zp0; rz[1] = *(const h8*)(zp0 + 8); }
#pragma unroll
    for (int e = 0; e < 2; ++e) {
      int id = tid + NTH * e; int row = id >> 4, c16 = id & 15;
      rw[e] = *(const h8*)(WG + (m0 + row) * 512 + h * 128 + c16 * 8);
      rq[e] = *(const h8*)(QG + (m0 + row) * 512 + h * 128 + c16 * 8);
      ru[e] = *(const h8*)(UG + (m0 + row) * 512 + h * 128 + c16 * 8);
      rk[e] = *(const h8*)(KTG + cid * 8192 + id * 8);
    }
    ra = *(const h8*)(AQK + cid * 4096 + tid * 8);
  };
  prefetch(0);
  const float* og = p.gdn_out_norm + l * 128;
  for (int n = 0; n < 64; ++n) {
#pragma unroll
    for (int e = 0; e < 2; ++e) {
      int id = tid + NTH * e; int row = id >> 4, c16 = id & 15;
      *(h8*)(Wl + row * 136 + c16 * 8) = rw[e];
      *(h8*)(Ql + row * 136 + c16 * 8) = rq[e];
      *(h8*)(Ul + row * 136 + c16 * 8) = ru[e];
      int krow = id >> 3, kc = id & 7;
      *(h8*)(Ktl + krow * 72 + kc * 8) = rk[e];
    }
    { int row = tid >> 3, kc = tid & 7; *(h8*)(Al + row * 72 + kc * 8) = ra; }
    zc[0] = rz[0]; zc[1] = rz[1];
    int zoff = 0; asm volatile("" : "+v"(zoff));
    const float egl = GL[(size_t)bh * 64 + n + zoff];
    __syncthreads();
    if (n + 1 < 64) prefetch(n + 1);
    h8 Sf[4];
#pragma unroll
    for (int s = 0; s < 4; ++s)
#pragma unroll
      for (int i = 0; i < 4; ++i) { Sf[s][i] = (half_t)St[2 * s][i]; Sf[s][4 + i] = (half_t)St[2 * s + 1][i]; }
#define SCHEDB __builtin_amdgcn_sched_barrier(0)
    f32x4 vn[4];
    {
      h8 fa[16]; float uu[16];
#pragma unroll
      for (int ct = 0; ct < 4; ++ct)
#pragma unroll
        for (int s = 0; s < 4; ++s) {
          h4 w0 = *(const h4*)(Wl + (16 * ct + l16) * 136 + 32 * s + 4 * quad);
          h4 w1 = *(const h4*)(Wl + (16 * ct + l16) * 136 + 32 * s + 16 + 4 * quad);
          fa[ct * 4 + s] = cat44(w0, w1);
        }
#pragma unroll
      for (int ct = 0; ct < 4; ++ct)
#pragma unroll
        for (int i = 0; i < 4; ++i) uu[ct * 4 + i] = (float)Ul[(16 * ct + 4 * quad + i) * 136 + 16 * wid + l16];
      SCHEDB;
      {
        f32x4 aa[4];
#pragma unroll
        for (int ct = 0; ct < 4; ++ct) aa[ct] = f32x4{0.f, 0.f, 0.f, 0.f};
#pragma unroll
        for (int s = 0; s < 4; ++s)
#pragma unroll
          for (int ct = 0; ct < 4; ++ct) aa[ct] = mfma16(fa[ct * 4 + s], Sf[s], aa[ct]);
#pragma unroll
        for (int ct = 0; ct < 4; ++ct)
#pragma unroll
          for (int i = 0; i < 4; ++i) vn[ct][i] = uu[ct * 4 + i] - aa[ct][i];
      }
      SCHEDB;
    }
    h8 Vf[2];
#pragma unroll
    for (int s = 0; s < 2; ++s)
#pragma unroll
      for (int i = 0; i < 4; ++i) { Vf[s][i] = (half_t)vn[2 * s][i]; Vf[s][4 + i] = (half_t)vn[2 * s + 1][i]; }
    f32x4 oacc[4];
    {
      h8 fq[16];
#pragma unroll
      for (int ct = 0; ct < 4; ++ct)
#pragma unroll
        for (int s = 0; s < 4; ++s) {
          h4 q0 = *(const h4*)(Ql + (16 * ct + l16) * 136 + 32 * s + 4 * quad);
          h4 q1 = *(const h4*)(Ql + (16 * ct + l16) * 136 + 32 * s + 16 + 4 * quad);
          fq[ct * 4 + s] = cat44(q0, q1);
        }
      SCHEDB;
#pragma unroll
      for (int ct = 0; ct < 4; ++ct) oacc[ct] = f32x4{0.f, 0.f, 0.f, 0.f};
#pragma unroll
      for (int s = 0; s < 4; ++s)
#pragma unroll
        for (int ct = 0; ct < 4; ++ct) oacc[ct] = mfma16(fq[ct * 4 + s], Sf[s], oacc[ct]);
      SCHEDB;
    }
    {
      h8 fb[8];
#pragma unroll
      for (int ct = 0; ct < 4; ++ct)
#pragma unroll
        for (int s = 0; s < 2; ++s) {
          h4 a0 = *(const h4*)(Al + (16 * ct + l16) * 72 + 32 * s + 4 * quad);
          h4 a1 = *(const h4*)(Al + (16 * ct + l16) * 72 + 32 * s + 16 + 4 * quad);
          fb[ct * 2 + s] = cat44(a0, a1);
        }
      SCHEDB;
#pragma unroll
      for (int s = 0; s < 2; ++s)
#pragma unroll
        for (int ct = 0; ct < 4; ++ct) oacc[ct] = mfma16(fb[ct * 2 + s], Vf[s], oacc[ct]);
#pragma unroll
      for (int ct = 0; ct < 4; ++ct)
#pragma unroll
        for (int i = 0; i < 4; ++i) ost[(16 * ct + 4 * quad + i) * 132 + 16 * wid + l16] = oacc[ct][i];
      SCHEDB;
    }
    {
      h8 fk[16];
#pragma unroll
      for (int Tt = 0; Tt < 8; ++Tt)
#pragma unroll
        for (int s = 0; s < 2; ++s) {
          h4 k0 = *(const h4*)(Ktl + (16 * Tt + l16) * 72 + 32 * s + 4 * quad);
          h4 k1 = *(const h4*)(Ktl + (16 * Tt + l16) * 72 + 32 * s + 16 + 4 * quad);
          fk[Tt * 2 + s] = cat44(k0, k1);
        }
      SCHEDB;
#pragma unroll
      for (int Tt = 0; Tt < 8; ++Tt) St[Tt] = St[Tt] * egl;
#pragma unroll
      for (int s = 0; s < 2; ++s)
#pragma unroll
        for (int Tt = 0; Tt < 8; ++Tt) St[Tt] = mfma16(fk[Tt * 2 + s], Vf[s], St[Tt]);
      SCHEDB;
    }
    __syncthreads();
    {
      int r = tid >> 3, seg = tid & 7; long m = (long)b * T_ + n * 64 + r;
      float o[16]; float ss = 0.f;
#pragma unroll
      for (int e = 0; e < 16; ++e) { o[e] = ost[r * 132 + seg * 16 + e]; ss += o[e] * o[e]; }
      ss += __shfl_xor(ss, 1); ss += __shfl_xor(ss, 2); ss += __shfl_xor(ss, 4);
      float rr = rsqrtf(ss * (1.f / 128.f) + EPS);
      half_t* zp = proj + m * PL + 512 + h * 128 + seg * 16;
      h8 z0 = zc[0], z1 = zc[1], o0, o1;
#pragma unroll
      for (int e = 0; e < 8; ++e) {
        o0[e] = (half_t)(o[e] * rr * og[seg * 16 + e] * silu_fast((float)z0[e]));
        o1[e] = (half_t)(o[8 + e] * rr * og[seg * 16 + 8 + e] * silu_fast((float)z1[e]));
      }
      half_t* op = dry ? zp + (1792 - 512) : zp;
      *(h8*)op = o0; *(h8*)(op + 8) = o1;
    }
  }
  __syncthreads();
}

#define XB_TMO      128
#define XB_XCNT(j)  (256  + 64 * (j))
#define XB_XSUB(j)  (1280 + 64 * (j))
#define XB_XGEN(j)  (2304 + 64 * (j))
#define XB_TOP      3328
#define XB_TOPGEN   3392
#define XCD_BAR_WORDS 3456
#define XB_SPIN_CAP (1u << 18)
#define LAS __attribute__((address_space(3)))

__device__ __forceinline__ unsigned xb_ld(unsigned* p)              { return __hip_atomic_load(p, __ATOMIC_RELAXED, __HIP_MEMORY_SCOPE_AGENT); }
__device__ __forceinline__ unsigned xb_add(unsigned* p, unsigned v) { return __hip_atomic_fetch_add(p, v, __ATOMIC_RELAXED, __HIP_MEMORY_SCOPE_AGENT); }
__device__ __forceinline__ unsigned xb_xcc_id() { return (unsigned)__builtin_amdgcn_s_getreg((3 << 11) | 20) & 0xFu; }
#define XB_SPIN(cond, bar) do { unsigned _sp = 0; while (cond) { __builtin_amdgcn_s_sleep(1); \
    if ((++_sp & 255u) == 0u) { if (xb_ld(&(bar)[XB_TMO])) break; if (_sp > XB_SPIN_CAP) { atomicAdd(&(bar)[XB_TMO], 1u); break; } } } } while (0)

struct XcdBarrier {
    unsigned* bar; unsigned x;
    volatile LAS unsigned* st;
};

__device__ __forceinline__ XcdBarrier xcd_barrier_post(unsigned* bar, volatile LAS unsigned* st) {
    XcdBarrier b; b.bar = bar; b.x = xb_xcc_id(); b.st = st;
    if (threadIdx.x == 0) (void)xb_add(&bar[XB_XCNT(b.x)], 1u);
    return b;
}
__device__ __forceinline__ void xcd_barrier_complete(unsigned* bar, unsigned x, unsigned& nloc, unsigned& nx) {
    const unsigned G = gridDim.x * gridDim.y * gridDim.z;
    unsigned sum, cnt, mine, sp = 0u;
    for (;;) {
        sum = 0u; cnt = 0u; mine = 0u;
#pragma unroll
        for (unsigned j = 0; j < 16; ++j) { const unsigned c = xb_ld(&bar[XB_XCNT(j)]); sum += c; cnt += (c > 0u) ? 1u : 0u; mine = (j == x) ? c : mine; }
        if (sum == G) break;
        __builtin_amdgcn_s_sleep(1);
        if ((++sp & 255u) == 0u) { if (xb_ld(&bar[XB_TMO])) break; if (sp > XB_SPIN_CAP) { atomicAdd(&bar[XB_TMO], 1u); break; } }
    }
    nloc = mine > 0u ? mine : 1u; nx = cnt > 0u ? cnt : 1u;
}

__device__ __forceinline__ void xcd_barrier(const XcdBarrier& b) {
    asm volatile("s_waitcnt vmcnt(0)" ::: "memory");
    __syncthreads();
    if (threadIdx.x == 0) {
        unsigned* bar = b.bar;
        __builtin_amdgcn_s_waitcnt(0);
        unsigned nloc = b.st[0], nx = b.st[1];
        if (nloc == 0u) { xcd_barrier_complete(bar, b.x, nloc, nx); b.st[0] = nloc; b.st[1] = nx; }
        const unsigned old = xb_add(&bar[XB_XSUB(b.x)], 1u);
        const unsigned gen = old / nloc;
        if (old + 1u == (gen + 1u) * nloc) {
            __builtin_amdgcn_fence(__ATOMIC_RELEASE, "agent");
            asm volatile("s_waitcnt vmcnt(0)" ::: "memory");
            const unsigned og = xb_add(&bar[XB_TOP], 1u);
            const unsigned tg = og / nx;
            if (og + 1u == (tg + 1u) * nx) xb_add(&bar[XB_TOPGEN], 1u);
            else XB_SPIN(xb_ld(&bar[XB_TOPGEN]) == tg, bar);
            __builtin_amdgcn_fence(__ATOMIC_ACQUIRE, "agent");
            xb_add(&bar[XB_XGEN(b.x)], 1u);
            asm volatile("s_waitcnt vmcnt(0)" ::: "memory");
        } else {
            XB_SPIN(xb_ld(&bar[XB_XGEN(b.x)]) == gen, bar);
            __builtin_amdgcn_fence(__ATOMIC_ACQUIRE, "agent");
            asm volatile("s_waitcnt vmcnt(0)" ::: "memory");
        }
    }
    __syncthreads();
}


DI void grid_barrier(unsigned* cnt, unsigned target) {
  asm volatile("s_waitcnt vmcnt(0) lgkmcnt(0)" ::: "memory");
  __syncthreads();
  if (threadIdx.x == 0) {
    __builtin_amdgcn_fence(__ATOMIC_RELEASE, "agent");
    asm volatile("s_waitcnt vmcnt(0)" ::: "memory");
    __hip_atomic_fetch_add(cnt, 1u, __ATOMIC_RELAXED, __HIP_MEMORY_SCOPE_AGENT);
    while (__hip_atomic_load(cnt, __ATOMIC_RELAXED, __HIP_MEMORY_SCOPE_AGENT) < target) __builtin_amdgcn_s_sleep(1);
    __builtin_amdgcn_fence(__ATOMIC_ACQUIRE, "agent");
    asm volatile("s_waitcnt vmcnt(0) lgkmcnt(0)" ::: "memory");
  }
  __syncthreads();
}

__global__ void __launch_bounds__(NTH, 2) fwd_mega(Params p) {
  extern __shared__ __attribute__((aligned(16))) char smem[];
  cg::grid_group grid = cg::this_grid();
#ifndef PROBE_K
#define PROBE_K -1
#endif
#ifndef PROBE_K2
#define PROBE_K2 -1
#endif
  bool first = true; int repflag = 0; int nbar = 0;
  char* const ws_base = p.ws;
  volatile LAS unsigned* xst = (volatile LAS unsigned*)(smem + LDS_BYTES - 16);
  if (threadIdx.x < 4) xst[threadIdx.x] = 0u;
  __syncthreads();
  XcdBarrier xb = xcd_barrier_post((unsigned*)(p.ws + WS_END), xst);
  for (int ph = p.phase_lo; ph < p.phase_hi;) {
    if (ph % 9 == 2 || ph % 9 == 4 || (ph % 9 == 0 && ph > 0)) { ++ph; continue; }
    if (!first) {
      if (nbar == 0) grid.sync();
      else xcd_barrier(xb);
      ++nbar;
    }
    first = false;
    const int ph_cur = ph;
    {
      const int kk = ph % 9;
      if ((kk == PROBE_K || kk == PROBE_K2) && !repflag && (PROBE_K != 6 || ph < 9)) { repflag = 1; }
      else if (PROBE_K == 15 && kk == 5 && !repflag) { repflag = 1; ph -= 4; }
      else { if (PROBE_K != 15 || kk == 5) repflag = 0; ++ph; }
    }
    { size_t zoffs = 0; asm volatile("" : "+s"(zoffs)); p.ws = ws_base + zoffs; }
    char* ws = p.ws;
    const int l = ph_cur / 9, k = ph_cur % 9;
    if (k == 0) {
      for (int ll = 0; ll < 4; ++ll) phase_weights(p, ll, smem);
    } else if (k == 1) {
      GArgs g{}; g.A = (const half_t*)(ws + WS_XH + 8192); g.lda = 1024; g.Bt = (const half_t*)(ws + wset(l) + WS_WIN); g.K = 1024; g.nM = 128; g.nN = 14;
      g.rss = (const float*)(ws + WS_RSS); g.outh = (half_t*)(ws + WS_PROJ); g.ldo = PL;
      g.cs = (const float*)(ws + WS_COS); g.sn = (const float*)(ws + WS_SIN); g.qg = p.q_norm + l * 64;
      g.kg1 = p.k_norm + (l * 3 + 1) * 64; g.kg2 = p.k_norm + (l * 3 + 2) * 64;
      g.kcr = (half_t*)(ws + WS_KCR); g.vcr = (half_t*)(ws + WS_VCR); g.vst = (half_t*)(ws + WS_VST); g.vwt = (half_t*)(ws + WS_VWT); g.kst = (half_t*)(ws + WS_KST);
      gemm_phase<EPI_IN>(g, smem);
    } else if (k == 3) {
      GArgs g{}; g.lda = 1024; g.K = 2048; g.nM = 16; g.nN = 1; g.ldo = 256;
      for (int it = blockIdx.x; it < 32; it += gridDim.x) {
        int kv = it >> 4, pm = it & 15;
        g.A = (const half_t*)(ws + (kv ? WS_VCR : WS_KCR)); g.Bt = (const half_t*)(ws + wset(l) + WS_WC1) + (size_t)kv * 256 * 2048;
        g.c1p = (const float*)(ws + wset(l) + WS_C1P) + kv * 256; g.kv = kv;
        g.w2t = (const half_t*)(ws + w2t_off(l)) + (size_t)kv * 64 * 256; g.kc = (half_t*)(ws + WS_KC); g.vct = (half_t*)(ws + WS_VCT); g.kg0 = p.k_norm + (l * 3 + 0) * 64;
        gemm_tile<EPI_CMP>(g, pm, 0, smem);
      }
#ifndef NOGDN
      if (blockIdx.x < 32) { for (int it = blockIdx.x * 6; it < blockIdx.x * 6 + 6; ++it) gdn_pre_item(p, l, it, smem); }
      else { for (int it = 192 + (blockIdx.x - 32); it < 2048; it += gridDim.x - 32) gdn_pre_item(p, l, it, smem); }
#endif
    } else if (k == 5) {
#ifndef PROBE_DRY
#define PROBE_DRY 0
#endif
      for (int pass = (PROBE_DRY ? 0 : 1); pass < 2; ++pass) {
        const int dry = (pass == 0);
        if (pass == 1 && PROBE_DRY) grid.sync();
        if (blockIdx.x < 32) { if (!dry || PROBE_DRY == 1) gdn_scan_item(p, l, blockIdx.x, smem, dry); }
        else if (!dry || PROBE_DRY == 2) {
          const int nb = gridDim.x - 32, bi = blockIdx.x - 32;
          for (int r = 0; r * nb < 1024; ++r) { int it = r * nb + ((r & 1) ? nb - 1 - bi : bi); if (it < 1024) nsa_item(p, l, it, smem, dry); }
        }
      }
    } else if (k == 6) {
      GArgs g{}; g.A = (const half_t*)(ws + WS_PROJ); g.lda = PL; g.Bt = (const half_t*)(ws + wset(l) + WS_WOUT); g.K = 1024; g.nM = 128; g.nN = 4;
      g.xout = nullptr; g.rss_out = (float*)(ws + WS_RSS);
      g.outh = (half_t*)(ws + WS_XH + 8192); g.ldo = 1024;
      gemm_phase<EPI_RES>(g, smem);
    } else if (k == 7) {
      GArgs g{}; g.A = (const half_t*)(ws + WS_XH + 8192); g.lda = 1024; g.Bt = (const half_t*)(ws + wset(l) + WS_WUP); g.K = 1024; g.nM = 128; g.nN = 22;
      g.hf = (half_t*)(ws + WS_HF); g.hl = (half_t*)(ws + WS_HL);
      g.rss = (const float*)(ws + WS_RSS); g.outh = (half_t*)(ws + WS_PROJ); g.ldo = NFF;
      g.convw = p.ffn_conv_w + (size_t)l * 3 * 5632; g.convb = p.ffn_conv_b + (size_t)l * 5632;
      gemm_phase<EPI_UP>(g, smem);
    } else {
      GArgs g{}; g.A = (const half_t*)(ws + WS_PROJ); g.lda = NFF; g.Bt = (const half_t*)(ws + wset(l) + WS_WDOWN); g.K = 2816; g.nM = 128; g.nN = 4;
      g.hf = (half_t*)(ws + WS_HF); g.hl = (half_t*)(ws + WS_HL); g.convw = p.ffn_conv_w + (size_t)l * 3 * 5632; g.convb = p.ffn_conv_b + (size_t)l * 5632;
      g.xout = (l < 3) ? nullptr : p.out; g.rss_out = (float*)(ws + WS_RSS);
      g.outh = (half_t*)(ws + WS_XH + 8192); g.ldo = 1024;
      gemm_phase<EPI_RES>(g, smem);
    }
  }
}

extern "C" void kernel_launch(void* const* d_in, const int* in_sizes, int n_in, void* d_out, int out_size, void* d_ws, size_t ws_size,
                              hipStream_t stream) {
  static int grid_blocks = 0;
  if (!grid_blocks) {
    if (ws_size < WS_END + XCD_BAR_WORDS * 4) { fprintf(stderr, "kernel_launch: workspace too small: %zu < %zu\n", ws_size, (size_t)WS_END); grid_blocks = -1; }
    else {
      int dev = 0, cus = 0, per_cu = 0;
      hipGetDevice(&dev);
      hipDeviceGetAttribute(&cus, hipDeviceAttributeMultiprocessorCount, dev);
      hipFuncSetAttribute((const void*)fwd_mega, hipFuncAttributeMaxDynamicSharedMemorySize, LDS_BYTES);
      hipOccupancyMaxActiveBlocksPerMultiprocessor(&per_cu, fwd_mega, NTH, LDS_BYTES);
      if (per_cu < 1) per_cu = 1;
      grid_blocks = cus < 64 ? -1 : cus;
    }
  }
  if (grid_blocks <= 0) return;
  Params p{};
  p.x = (const float*)d_in[0]; p.pos = (const int*)d_in[1]; p.attn_norm = (const float*)d_in[2]; p.w_in = (const float*)d_in[3];
  p.q_norm = (const float*)d_in[4]; p.k_norm = (const float*)d_in[5]; p.cmp_pe = (const float*)d_in[6]; p.cmp_w1 = (const float*)d_in[7];
  p.cmp_w2 = (const float*)d_in[8]; p.nsa_out_norm = (const float*)d_in[9]; p.gdn_conv_w = (const float*)d_in[10];
  p.gdn_a_log = (const float*)d_in[11]; p.gdn_dt_bias = (const float*)d_in[12]; p.gdn_out_norm = (const float*)d_in[13];
  p.w_out = (const float*)d_in[14]; p.ffn_norm = (const float*)d_in[15]; p.w_up = (const float*)d_in[16]; p.ffn_conv_w = (const float*)d_in[17];
  p.ffn_conv_b = (const float*)d_in[18]; p.w_down = (const float*)d_in[19];
  p.out = (float*)d_out; p.ws = (char*)d_ws; p.phase_lo = 0; p.phase_hi = 36;
  (void)hipMemsetAsync((char*)d_ws + WS_END, 0, XCD_BAR_WORDS * 4, stream);
  void* args[] = {&p};
  hipError_t e = hipLaunchCooperativeKernel((void*)fwd_mega, dim3(grid_blocks), dim3(NTH), args, LDS_BYTES, stream);
  if (e != hipSuccess) fprintf(stderr, "cooperative launch failed: %s (grid %d)\n", hipGetErrorString(e), grid_blocks);
}
```

```cpp
#include <hip/hip_runtime.h>
#include <hip/hip_cooperative_groups.h>
#include <cstdio>
#include <cstdint>
namespace cg = cooperative_groups;

typedef _Float16 half_t;
typedef _Float16 h8 __attribute__((ext_vector_type(8)));
typedef _Float16 h4 __attribute__((ext_vector_type(4)));
typedef float f32x4 __attribute__((ext_vector_type(4)));
typedef float f32x16 __attribute__((ext_vector_type(16)));
#define DI __device__ __forceinline__

constexpr int M_ = 32768, T_ = 4096, D_ = 1024, PL = 3584, NFF = 2816;
constexpr int NTH = 512;
constexpr int LDS_BYTES = 163840;
constexpr float EPS = 1e-6f;

constexpr size_t AL(size_t x) { return (x + 255) & ~(size_t)255; }
constexpr size_t WS_WIN = 0;
constexpr size_t WS_WOUT = WS_WIN + AL((size_t)PL * 1024 * 2);
constexpr size_t WS_WUP = WS_WOUT + AL((size_t)1024 * 1024 * 2);
constexpr size_t WS_WDOWN = WS_WUP + AL((size_t)5632 * 1024 * 2);
constexpr size_t WS_WC1 = WS_WDOWN + AL((size_t)1024 * 2816 * 2);
constexpr size_t WS_C1P = WS_WC1 + AL((size_t)2 * 256 * 2048 * 2);
constexpr size_t WS_COS = WS_C1P + AL((size_t)16 * 512 * 4);
constexpr size_t WS_SIN = WS_COS + AL((size_t)M_ * 8 * 4);
constexpr size_t WS_RSS = WS_SIN + AL((size_t)M_ * 8 * 4);
constexpr size_t WS_XH = WS_RSS + AL((size_t)M_ * 4 * 4);
constexpr size_t WS_PROJ = WS_XH + AL((size_t)(M_ + 264) * 1024 * 2);
constexpr size_t WS_KCR = WS_PROJ + AL((size_t)M_ * PL * 2);
constexpr size_t WS_VCR = WS_KCR + AL(((size_t)16 * 4096 * 64 + 4096) * 2);
constexpr size_t WS_HID = WS_VCR + AL(((size_t)16 * 4096 * 64 + 4096) * 2);
constexpr size_t WS_KC = WS_HID + AL((size_t)2 * 4096 * 256 * 2);
constexpr size_t WS_VCT = WS_KC + AL((size_t)16 * 256 * 64 * 2);
constexpr size_t WS_VST = WS_VCT + AL((size_t)16 * 256 * 64 * 2);
constexpr size_t WS_VWT = WS_VST + AL((size_t)16 * 64 * 4096 * 2);
constexpr size_t WS_WG = WS_VWT + AL((size_t)16 * 64 * 4096 * 2);
constexpr size_t WS_QG = WS_WG + AL((size_t)M_ * 512 * 2);
constexpr size_t WS_UG = WS_QG + AL((size_t)M_ * 512 * 2);
constexpr size_t WS_KTG = WS_UG + AL((size_t)M_ * 512 * 2);
constexpr size_t WS_AQK = WS_KTG + AL((size_t)2048 * 128 * 64 * 2);
constexpr size_t WS_GL = WS_AQK + AL((size_t)2048 * 64 * 64 * 2);
constexpr size_t WS_END = WS_GL + AL((size_t)2048 * 4);

__constant__ float ROPE_INV[8] = {1.000000000e+00f,1.939227432e-01f,3.760603070e-02f,7.292664610e-03f,1.414213562e-03f,2.742481884e-04f,5.318295734e-05f,1.031338525e-05f};

constexpr size_t WSET_STRIDE = AL(WS_COS + 65536);
constexpr size_t WS_HF = WS_WG + 4 * WSET_STRIDE;
constexpr size_t WS_HL = WS_HF + AL((size_t)128 * 2 * 5632 * 2);
static_assert(WS_HL + (size_t)128 * 2 * 5632 * 2 <= WS_AQK, "halo buffers must fit the free region");
DI size_t wset(int l) { return WS_WG + (size_t)l * WSET_STRIDE; }
DI size_t w2t_off(int l) { return WS_WG + (size_t)l * WSET_STRIDE + WS_COS; }

struct Params {
  const float* x; const int* pos; const float* attn_norm; const float* w_in; const float* q_norm; const float* k_norm;
  const float* cmp_pe; const float* cmp_w1; const float* cmp_w2; const float* nsa_out_norm; const float* gdn_conv_w;
  const float* gdn_a_log; const float* gdn_dt_bias; const float* gdn_out_norm; const float* w_out; const float* ffn_norm;
  const float* w_up; const float* ffn_conv_w; const float* ffn_conv_b; const float* w_down;
  float* out; char* ws; int phase_lo; int phase_hi;
};

DI float sigm(float x) { return 1.f / (1.f + expf(-x)); }
DI float siluf(float x) { return x / (1.f + expf(-x)); }
DI float silu_fast(float x) { return x * __frcp_rn(1.f + __expf(-x)); }
DI f32x16 mfma32(h8 a, h8 b, f32x16 c) { return __builtin_amdgcn_mfma_f32_32x32x16_f16(a, b, c, 0, 0, 0); }
DI f32x4 mfma16(h8 a, h8 b, f32x4 c) { return __builtin_amdgcn_mfma_f32_16x16x32_f16(a, b, c, 0, 0, 0); }
DI h8 cat44(h4 a, h4 b) { return __builtin_shufflevector(a, b, 0, 1, 2, 3, 4, 5, 6, 7); }
DI char* lws(const Params& p) { char* w = p.ws; asm volatile("" : "+s"(w)); return w; }
DI int ltid() { int t = threadIdx.x; asm volatile("" : "+v"(t)); return t; }
typedef _Float16 h2 __attribute__((ext_vector_type(2)));
#define EXP2(x) __builtin_amdgcn_exp2f(x)
DI int crow(int reg, int hf) { return (reg & 3) + 8 * (reg >> 2) + 4 * hf; }

DI int map_in(int c) {
  if (c < 512) return c;
  if (c < 1024) return 2848 + (c - 512);
  if (c < 1792) return 512 + (c - 1024);
  if (c < 3328) return 1304 + (c - 1792);
  if (c < 3352) return 1280 + (c - 3328);
  if (c < 3360) return 2840 + (c - 3352);
  return -1;
}
DI int map_up(int c) { int n = c >> 8, j = c & 255; return j < 128 ? n * 128 + j : 2816 + n * 128 + (j - 128); }

template <int MAP>
__device__ void conv_transpose(const float* __restrict__ W, int K, int No, half_t* __restrict__ Wt, int Np, char* smem, const float* __restrict__ rs = nullptr) {
  float* tile = (float*)smem;
  const int tid = ltid();
  const int ntn = Np / 64, ntk = K / 64;
  for (int t = blockIdx.x; t < ntn * ntk; t += gridDim.x) {
    int tn = t % ntn, tk = t / ntn;
#pragma unroll
    for (int e = 0; e < 8; ++e) {
      int idx = tid + NTH * e; int kk = idx >> 6, nn = idx & 63;
      int np = tn * 64 + nn;
      int on = MAP == 1 ? map_in(np) : (MAP == 2 ? map_up(np) : np);
      float v = on >= 0 ? W[(size_t)(tk * 64 + kk) * No + on] : 0.f;
      if (rs) v *= rs[tk * 64 + kk];
      tile[kk * 65 + nn] = v;
    }
    __syncthreads();
    {
      int nn = tid >> 3, kg = tid & 7; h8 v;
#pragma unroll
      for (int j = 0; j < 8; ++j) v[j] = (half_t)tile[(kg * 8 + j) * 65 + nn];
      *(h8*)(Wt + (size_t)(tn * 64 + nn) * K + tk * 64 + kg * 8) = v;
    }
    __syncthreads();
  }
}

__device__ void phase_weights(const Params& p, int l, char* smem) {
  char* ws = p.ws + wset(l);
  conv_transpose<1>(p.w_in + (size_t)l * 1024 * 3360, 1024, 3360, (half_t*)(ws + WS_WIN), PL, smem, p.attn_norm + l * 1024);
  conv_transpose<0>(p.w_out + (size_t)l * 1024 * 1024, 1024, 1024, (half_t*)(ws + WS_WOUT), 1024, smem);
  conv_transpose<2>(p.w_up + (size_t)l * 1024 * 5632, 1024, 5632, (half_t*)(ws + WS_WUP), 5632, smem, p.ffn_norm + l * 1024);
  conv_transpose<0>(p.w_down + (size_t)l * 2816 * 1024, 2816, 1024, (half_t*)(ws + WS_WDOWN), 1024, smem);
  for (int kv = 0; kv < 2; ++kv)
    conv_transpose<0>(p.cmp_w1 + (size_t)(l * 2 + kv) * 2048 * 256, 2048, 256, (half_t*)(ws + WS_WC1) + (size_t)kv * 256 * 2048, 256, smem);
  for (int kv = 0; kv < 2; ++kv)
    conv_transpose<0>(p.cmp_w2 + (size_t)(l * 2 + kv) * 256 * 64, 256, 64, (half_t*)(p.ws + w2t_off(l)) + (size_t)kv * 64 * 256, 64, smem);
  float* c1p = (float*)(ws + WS_C1P);
  for (int it = blockIdx.x; it < 32; it += gridDim.x) {
    int kv = it >> 4, kc = it & 15; int n = ltid();
    if (n < 256) {
      const float* pe = p.cmp_pe + (size_t)(l * 2 + kv) * 2048 + kc * 128;
      const float* w1 = p.cmp_w1 + ((size_t)(l * 2 + kv) * 2048 + kc * 128) * 256 + n;
      float s = 0.f;
      for (int k = 0; k < 128; ++k) s += pe[k] * w1[(size_t)k * 256];
      c1p[kc * 512 + kv * 256 + n] = s;
    }
  }
  if (l == 0) {
    half_t* xh = (half_t*)(p.ws + WS_XH + 8192); float* rss = (float*)(p.ws + WS_RSS);
    float* cs = (float*)(p.ws + WS_COS); float* sn = (float*)(p.ws + WS_SIN);
    const int tidw = ltid(); const int wid = tidw >> 6, lane = tidw & 63;
    for (int row = blockIdx.x * 8 + wid; row < M_; row += gridDim.x * 8) {
      const float* xr = p.x + (size_t)row * 1024;
      float ss = 0.f;
#pragma unroll
      for (int e = 0; e < 2; ++e) {
        int c = (e * 64 + lane) * 8;
        float4 a = *(const float4*)(xr + c), b = *(const float4*)(xr + c + 4);
        float4 ga = {1.f, 1.f, 1.f, 1.f}, gb = {1.f, 1.f, 1.f, 1.f};
        ss += a.x * a.x + a.y * a.y + a.z * a.z + a.w * a.w + b.x * b.x + b.y * b.y + b.z * b.z + b.w * b.w;
        h8 v; v[0] = (half_t)(a.x * ga.x); v[1] = (half_t)(a.y * ga.y); v[2] = (half_t)(a.z * ga.z); v[3] = (half_t)(a.w * ga.w);
        v[4] = (half_t)(b.x * gb.x); v[5] = (half_t)(b.y * gb.y); v[6] = (half_t)(b.z * gb.z); v[7] = (half_t)(b.w * gb.w);
        *(h8*)(xh + (size_t)row * 1024 + c) = v;
      }
#pragma unroll
      for (int o = 32; o >= 1; o >>= 1) ss += __shfl_xor(ss, o);
      if (lane == 0) { float4 r; r.x = ss; r.y = 0.f; r.z = 0.f; r.w = 0.f; *(float4*)(rss + (size_t)row * 4) = r; }
      if (lane < 8) {
        float inv = ROPE_INV[lane];
        float ang = (float)p.pos[row] * inv;
        cs[(size_t)row * 8 + lane] = cosf(ang);
        sn[(size_t)row * 8 + lane] = sinf(ang);
      }
    }
  }
}

DI int lds_byte(int r, int c) {
  int st = (r >> 4) * 2 + (c >> 5), rr = r & 15, cc = c & 31, ob = rr * 64 + cc * 2;
  return st * 1024 + (ob ^ (((ob >> 9) & 1) << 5));
}
DI void stage_rc(int b, int& R, int& C) {
  int st = b / 1024, sb = b % 1024, swz = sb ^ (((sb >> 9) & 1) << 5);
  R = (st >> 1) * 16 + swz / 64; C = (st & 1) * 32 + (swz % 64) / 2;
}

DI void gemm_kloop(const half_t* __restrict__ A0, const half_t* __restrict__ A1, const half_t* __restrict__ Bt0, const half_t* __restrict__ Bt1,
                   const unsigned (&oa)[2], const unsigned (&ob)[2], int nt, char* smem, f32x4 (&acc)[2][2][4][2], const int tid) {
  const int wid = tid >> 6, lane = tid & 63, wr = wid >> 2, wc = wid & 3, fr = lane & 15, fq = lane >> 4;
  constexpr int HTB = 128 * 64 * 2;
#define SA(b, h) (smem + ((b) * 2 + (h)) * HTB)
#define SB(b, h) (smem + (4 + (b) * 2 + (h)) * HTB)
#define STAGE(P, BASE, O, kt) do { for (int _i = 0; _i < 2; ++_i) { \
    __builtin_amdgcn_global_load_lds((const unsigned*)((BASE) + (long)(kt) * 64 + (O)[_i]), (unsigned*)((P) + tid * 16 + _i * 8192), 16, 0, 0); } } while (0)
#define LDA(dst, b, h) for (int m = 0; m < 4; ++m) for (int k = 0; k < 2; ++k) \
    dst[m][k] = *reinterpret_cast<const h8*>(SA(b, h) + lds_byte(wr * 64 + m * 16 + fr, k * 32 + fq * 8))
#define LDB(dst, b, h) for (int n = 0; n < 2; ++n) for (int k = 0; k < 2; ++k) \
    dst[n][k] = *reinterpret_cast<const h8*>(SB(b, h) + lds_byte(wc * 32 + n * 16 + fr, k * 32 + fq * 8))
#define MMA(ai, bj, At_, Bt_) do { __builtin_amdgcn_s_setprio(1); \
    for (int m = 0; m < 4; ++m) for (int n = 0; n < 2; ++n) for (int k = 0; k < 2; ++k) \
      acc[ai][bj][m][n] = mfma16(Bt_[n][k], At_[m][k], acc[ai][bj][m][n]); \
    __builtin_amdgcn_s_setprio(0); } while (0)
#define WAIT_V(n) asm volatile("s_waitcnt vmcnt(" #n ")" ::: "memory")
#define WAIT_L(n) asm volatile("s_waitcnt lgkmcnt(" #n ")" ::: "memory")
#define BAR __builtin_amdgcn_s_barrier()
#define SCHED __builtin_amdgcn_sched_barrier(0)
  h8 At[4][2], B0[2][2], B1[2][2];
#pragma unroll
  for (int a = 0; a < 2; ++a) for (int b = 0; b < 2; ++b) for (int m = 0; m < 4; ++m) for (int n = 0; n < 2; ++n) acc[a][b][m][n] = f32x4{0.f, 0.f, 0.f, 0.f};
  STAGE(SB(0, 0), Bt0, ob, 0); STAGE(SA(0, 0), A0, oa, 0);
  STAGE(SB(0, 1), Bt1, ob, 0); STAGE(SA(0, 1), A1, oa, 0);
  if (wr == 1) BAR;
  WAIT_V(4); BAR;
  STAGE(SB(1, 0), Bt0, ob, 1); STAGE(SA(1, 0), A0, oa, 1); STAGE(SB(1, 1), Bt1, ob, 1);
  WAIT_V(6); BAR;
  for (int t = 0; t < nt - 2; t += 2) {
    LDB(B0, 0, 0); SCHED; LDA(At, 0, 0); STAGE(SA(1, 1), A1, oa, t + 1);
    WAIT_L(8); BAR; WAIT_L(0); MMA(0, 0, At, B0); BAR; SCHED;
    LDB(B1, 0, 1); STAGE(SB(0, 0), Bt0, ob, t + 2);
    BAR; WAIT_L(0); MMA(0, 1, At, B1); BAR;
    LDA(At, 0, 1); STAGE(SA(0, 0), A0, oa, t + 2);
    BAR; WAIT_L(0); MMA(1, 0, At, B0); BAR; SCHED;
    STAGE(SB(0, 1), Bt1, ob, t + 2);
    WAIT_V(6); BAR; MMA(1, 1, At, B1); BAR;
    LDB(B0, 1, 0); SCHED; LDA(At, 1, 0); STAGE(SA(0, 1), A1, oa, t + 2);
    WAIT_L(8); BAR; WAIT_L(0); MMA(0, 0, At, B0); BAR; SCHED;
    LDB(B1, 1, 1); STAGE(SB(1, 0), Bt0, ob, t + 3);
    BAR; WAIT_L(0); MMA(0, 1, At, B1); BAR;
    LDA(At, 1, 1); STAGE(SA(1, 0), A0, oa, t + 3);
    BAR; WAIT_L(0); MMA(1, 0, At, B0); BAR; SCHED;
    STAGE(SB(1, 1), Bt1, ob, t + 3);
    WAIT_V(6); BAR; MMA(1, 1, At, B1); BAR;
  }
  { LDB(B0, 0, 0); LDA(At, 0, 0); STAGE(SA(1, 1), A1, oa, nt - 1);
    BAR; WAIT_L(0); MMA(0, 0, At, B0); BAR;
    LDB(B1, 0, 1); BAR; WAIT_L(0); MMA(0, 1, At, B1); BAR;
    LDA(At, 0, 1); WAIT_V(4); BAR; WAIT_L(0); MMA(1, 0, At, B0); MMA(1, 1, At, B1); BAR; }
  { LDB(B0, 1, 0); LDA(At, 1, 0); WAIT_V(2); BAR; WAIT_L(0); MMA(0, 0, At, B0); BAR;
    LDB(B1, 1, 1); WAIT_V(0); BAR; WAIT_L(0); MMA(0, 1, At, B1); BAR;
    LDA(At, 1, 1); BAR; WAIT_L(0); MMA(1, 0, At, B0); MMA(1, 1, At, B1); BAR; }
  if (wr == 0) BAR;
#undef SA
#undef SB
#undef STAGE
#undef LDA
#undef LDB
#undef MMA
#undef WAIT_V
#undef WAIT_L
#undef BAR
#undef SCHED
}

enum { EPI_IN = 0, EPI_RES = 1, EPI_UP = 2, EPI_CMP = 3 };
struct GArgs {
  const half_t* A; long lda; const half_t* Bt; int K; int nM; int nN;
  const float* rss; half_t* outh; long ldo;
  const float* resid; float* xout; const float* gain_next; float* rss_out;
  const float* convw; const float* convb; const float* c1p;
  const float* cs; const float* sn; const float* qg; const float* kg1; const float* kg2;
  half_t* kcr; half_t* vcr; half_t* vst; half_t* vwt;
  const half_t* w2t; half_t* kc; half_t* vct; const float* kg0; int kv;
  half_t* hf; half_t* hl;
};

constexpr int TS = 264;

DI void tile_copy_out(const char* smem, half_t* out, long ldo, long grow0, int gcol0, int tid) {
#pragma unroll
  for (int e = 0; e < 16; ++e) {
    int id = tid + NTH * e; int row = id >> 5, c16 = id & 31;
    h8 v = *(const h8*)(smem + (row * TS + c16 * 8) * 2);
    *(h8*)(out + (grow0 + row) * ldo + gcol0 + c16 * 8) = v;
  }
}

template <int EPI>
__device__ void gemm_tile(const GArgs& g, int pm, int pn, char* smem) {
  int tid = ltid();
  const long brow = (long)pm * 256;
  const int bcol = pn * 256;
  if (EPI == EPI_RES) {
    if (g.convw && (pm & 15) != 0) {
      const half_t* L = g.hl + (size_t)(pm - 1) * 2 * 5632; const half_t* F = g.hf + (size_t)pm * 2 * 5632;
      for (int idx = tid; idx < 2816; idx += NTH) {
        int pnn = idx >> 7, cc = idx & 127; int gcol = pnn * 256 + cc, ucol = gcol + 128;
        float wg0 = g.convw[idx], wg1 = g.convw[5632 + idx], wg2 = g.convw[2 * 5632 + idx];
        float wu0 = g.convw[2816 + idx], wu1 = g.convw[5632 + 2816 + idx], wu2 = g.convw[2 * 5632 + 2816 + idx];
        float bgv = g.convb[idx], buv = g.convb[2816 + idx];
        float L0g = (float)L[gcol], L1g = (float)L[5632 + gcol], F0g = (float)F[gcol], F1g = (float)F[5632 + gcol];
        float L0u = (float)L[ucol], L1u = (float)L[5632 + ucol], F0u = (float)F[ucol], F1u = (float)F[5632 + ucol];
        float y0g = wg2 * F0g + wg1 * L1g + wg0 * L0g + bgv, y0u = wu2 * F0u + wu1 * L1u + wu0 * L0u + buv;
        float y1g = wg2 * F1g + wg1 * F0g + wg0 * L1g + bgv, y1u = wu2 * F1u + wu1 * F0u + wu0 * L1u + buv;
        half_t* act = (half_t*)g.A;
        act[brow * NFF + idx] = (half_t)(silu_fast(y0g) * y0u);
        act[(brow + 1) * NFF + idx] = (half_t)(silu_fast(y1g) * y1u);
      }
      asm volatile("s_waitcnt vmcnt(0)" ::: "memory");
      __syncthreads();
    }
  }
  unsigned oa[2], ob[2];
#pragma unroll
  for (int i = 0; i < 2; ++i) {
    int R, C; stage_rc(tid * 16 + i * 8192, R, C);
    oa[i] = (unsigned)(R * (int)g.lda + C);
    ob[i] = (unsigned)(R * g.K + C);
  }
  f32x4 acc[2][2][4][2];
  gemm_kloop(g.A + brow * g.lda, g.A + (brow + 128) * g.lda, g.Bt + (long)bcol * g.K, g.Bt + (long)(bcol + 128) * g.K, oa, ob, g.K / 64, smem, acc, tid);
  __syncthreads();
  asm volatile("" : "+v"(tid));
  const int wid = tid >> 6, lane = tid & 63, wr = wid >> 2, wc = wid & 3, fr = lane & 15, fq = lane >> 4;
  float* aux = (float*)(smem + 256 * TS * 2);

  if (EPI == EPI_IN || EPI == EPI_UP) {
    float rs[2][4];
#pragma unroll
    for (int ai = 0; ai < 2; ++ai)
#pragma unroll
      for (int m = 0; m < 4; ++m) {
        long gr = brow + ai * 128 + wr * 64 + m * 16 + fr;
        gr = gr < 0 ? 0 : (gr > M_ - 1 ? M_ - 1 : gr);
        float4 s4 = *(const float4*)(g.rss + gr * 4);
        rs[ai][m] = rsqrtf((s4.x + s4.y + s4.z + s4.w) * (1.f / 1024.f) + EPS);
      }
#pragma unroll
    for (int ai = 0; ai < 2; ++ai) for (int bj = 0; bj < 2; ++bj) for (int m = 0; m < 4; ++m) for (int n = 0; n < 2; ++n) {
      int row = ai * 128 + wr * 64 + m * 16 + fr, col = bj * 128 + wc * 32 + n * 16 + fq * 4;
      f32x4 a = acc[ai][bj][m][n]; float s = rs[ai][m];
      h4 v; v[0] = (half_t)(a[0] * s); v[1] = (half_t)(a[1] * s); v[2] = (half_t)(a[2] * s); v[3] = (half_t)(a[3] * s);
      *(h4*)(smem + (row * TS + col) * 2) = v;
    }
    __syncthreads();
    if (EPI == EPI_IN) {
      if (pn <= 1 || (pn >= 4 && pn <= 6)) {
        half_t* tl = (half_t*)smem;
        const int sub = tid & 7;
        const int bb = (int)(brow >> 12), t0 = (int)(brow & (T_ - 1));
        const int nu = (pn <= 1) ? 4 : 2;
        const float* gain = (pn <= 1) ? g.qg : (pn == 5 ? g.kg1 : (pn == 6 ? g.kg2 : nullptr));
        const float scale = (pn <= 1) ? 0.125f * 1.4426950408889634f : 1.f;
        float gn8[8];
#pragma unroll
        for (int i = 0; i < 8; ++i) gn8[i] = gain ? gain[sub * 8 + i] : 1.f;
#pragma unroll 1
        for (int it = 0; it < 4; ++it) {
          const int row = (tid >> 3) + 64 * it; const long m = brow + row;
          float c8[8], s8[8];
#pragma unroll
          for (int i = 0; i < 8; ++i) { c8[i] = 1.f; s8[i] = 0.f; }
          if (sub < 2) {
#pragma unroll
            for (int i = 0; i < 8; ++i) { c8[i] = g.cs[m * 8 + i]; s8[i] = g.sn[m * 8 + i]; }
          }
#pragma unroll 1
          for (int u = 0; u < nu; ++u) {
            half_t* src = tl + row * TS + u * 64 + sub * 8;
            h8 v = *(const h8*)src; float f[8]; float ss = 0.f;
#pragma unroll
            for (int i = 0; i < 8; ++i) { f[i] = (float)v[i]; ss += f[i] * f[i]; }
            ss += __shfl_xor(ss, 1); ss += __shfl_xor(ss, 2); ss += __shfl_xor(ss, 4);
            if (gain) {
              float r = rsqrtf(ss * (1.f / 64.f) + EPS);
#pragma unroll
              for (int i = 0; i < 8; ++i) f[i] = f[i] * r * gn8[i];
            }
            h8 w;
#pragma unroll
            for (int i = 0; i < 8; ++i) {
              float other = __shfl_xor(f[i], 1);
              float o = f[i];
              if (sub == 0) o = f[i] * c8[i] - other * s8[i];
              else if (sub == 1) o = f[i] * c8[i] + other * s8[i];
              w[i] = (half_t)(o * scale);
            }
            *(h8*)src = w;
            if (pn == 4) *(h8*)(g.kcr + ((size_t)(bb * 2 + u) * T_ + t0 + row) * 64 + sub * 8) = w;
          }
        }
        if (pn == 4) {
#pragma unroll
          for (int e = 0; e < 8; ++e) {
            int id = tid + NTH * e; int row = id >> 4, gg = (id >> 3) & 1, c8i = id & 7;
            *(h8*)(g.vcr + ((size_t)(bb * 2 + gg) * T_ + t0 + row) * 64 + c8i * 8) = *(const h8*)(tl + row * TS + 128 + gg * 64 + c8i * 8);
          }
        } else if (pn >= 5) {
          half_t* vdst = (pn == 5) ? g.vst : g.vwt;
          const int d = tid >> 3, kc = tid & 7;
#pragma unroll 1
          for (int q = 0; q < 8; ++q) {
            int kb = q >> 1, gg = q & 1; h8 v;
#pragma unroll
            for (int i = 0; i < 8; ++i) v[i] = tl[(kb * 64 + kc * 8 + i) * TS + 128 + gg * 64 + d];
            *(h8*)(vdst + ((size_t)((bb * 2 + gg) * 64 + (t0 >> 6) + kb)) * 4096 + d * 64 + kc * 8) = v;
          }
        }
        __syncthreads();
      }
      tile_copy_out(smem, g.outh, g.ldo, brow, bcol, tid);
    } else {
      const int cgp = tid & 15;
      const int gc = pn * 128 + cgp * 8;
      float wg[3][8], wu[3][8], bg[8], bu[8];
#pragma unroll
      for (int j = 0; j < 3; ++j)
#pragma unroll
        for (int e = 0; e < 8; ++e) { wg[j][e] = g.convw[j * 5632 + gc + e]; wu[j][e] = g.convw[j * 5632 + 2816 + gc + e]; }
#pragma unroll
      for (int e = 0; e < 8; ++e) { bg[e] = g.convb[gc + e]; bu[e] = g.convb[2816 + gc + e]; }
      if (tid < 128) {
        int sel = tid >> 5, ch = tid & 31; int lr = sel < 2 ? sel : 252 + sel;
        half_t* dst = (sel < 2 ? g.hf : g.hl) + ((size_t)pm * 2 + (sel & 1)) * 5632 + pn * 256 + ch * 8;
        *(h8*)dst = *(const h8*)(smem + (lr * TS + ch * 8) * 2);
      }
      const bool seq_start = ((brow & (T_ - 1)) == 0);
#pragma unroll 1
      for (int e8 = 0; e8 < 8; ++e8) {
        int id = tid + NTH * e8; int lr = id >> 4;
        long gr = brow + lr;
        if (lr >= 2 || seq_start) {
          int t = (int)(gr & (T_ - 1));
          float m1 = t >= 1 ? 1.f : 0.f, m2 = t >= 2 ? 1.f : 0.f;
          const int lr1 = lr >= 1 ? lr - 1 : 0, lr2 = lr >= 2 ? lr - 2 : 0;
          h8 g0 = *(const h8*)(smem + (lr * TS + cgp * 8) * 2), g1 = *(const h8*)(smem + (lr1 * TS + cgp * 8) * 2), g2 = *(const h8*)(smem + (lr2 * TS + cgp * 8) * 2);
          h8 u0 = *(const h8*)(smem + (lr * TS + 128 + cgp * 8) * 2), u1 = *(const h8*)(smem + (lr1 * TS + 128 + cgp * 8) * 2), u2 = *(const h8*)(smem + (lr2 * TS + 128 + cgp * 8) * 2);
          h8 o;
#pragma unroll
          for (int e = 0; e < 8; ++e) {
            float yg = wg[2][e] * (float)g0[e] + m1 * wg[1][e] * (float)g1[e] + m2 * wg[0][e] * (float)g2[e] + bg[e];
            float yu = wu[2][e] * (float)u0[e] + m1 * wu[1][e] * (float)u1[e] + m2 * wu[0][e] * (float)u2[e] + bu[e];
            o[e] = (half_t)(silu_fast(yg) * yu);
          }
          *(h8*)(g.outh + gr * NFF + gc) = o;
        }
      }
    }
  } else if (EPI == EPI_RES) {
    float* S = (float*)smem;
#pragma unroll 1
    for (int ai = 0; ai < 2; ++ai) {
#pragma unroll
      for (int bj = 0; bj < 2; ++bj) for (int m = 0; m < 4; ++m) for (int n = 0; n < 2; ++n) {
        int row = wr * 64 + m * 16 + fr, col = bj * 128 + wc * 32 + n * 16 + fq * 4;
        f32x4 a = ai ? acc[1][bj][m][n] : acc[0][bj][m][n];
        *(f32x4*)(S + row * 260 + col) = a;
      }
      __syncthreads();
      {
        const long grow0 = brow + ai * 128 + wid * 16;
        h4 rv[16];
#pragma unroll
        for (int rr = 0; rr < 16; ++rr) rv[rr] = *(const h4*)(g.outh + (grow0 + rr) * g.ldo + bcol + lane * 4);
#pragma unroll
        for (int rr = 0; rr < 16; ++rr) {
          f32x4 a = *(const f32x4*)(S + (wid * 16 + rr) * 260 + lane * 4);
          float4 xn; xn.x = (float)rv[rr][0] + a[0]; xn.y = (float)rv[rr][1] + a[1]; xn.z = (float)rv[rr][2] + a[2]; xn.w = (float)rv[rr][3] + a[3];
          if (g.xout) {
            *(float4*)(g.xout + (grow0 + rr) * 1024 + bcol + lane * 4) = xn;
          } else {
            float ss = xn.x * xn.x + xn.y * xn.y + xn.z * xn.z + xn.w * xn.w;
#pragma unroll
            for (int o = 32; o >= 1; o >>= 1) ss += __shfl_xor(ss, o);
            if (lane == 0) g.rss_out[(grow0 + rr) * 4 + pn] = ss;
            h4 v; v[0] = (half_t)xn.x; v[1] = (half_t)xn.y; v[2] = (half_t)xn.z; v[3] = (half_t)xn.w;
            *(h4*)(g.outh + (grow0 + rr) * g.ldo + bcol + lane * 4) = v;
          }
        }
      }
      __syncthreads();
    }
  } else {
    if (tid < 256) { float s = 0.f; for (int kc = 0; kc < 16; ++kc) s += g.c1p[kc * 512 + tid]; aux[tid] = s; }
    __syncthreads();
#pragma unroll
    for (int ai = 0; ai < 2; ++ai) for (int bj = 0; bj < 2; ++bj) for (int m = 0; m < 4; ++m) for (int n = 0; n < 2; ++n) {
      int row = ai * 128 + wr * 64 + m * 16 + fr, col = bj * 128 + wc * 32 + n * 16 + fq * 4;
      f32x4 a = acc[ai][bj][m][n]; h4 v;
#pragma unroll
      for (int j = 0; j < 4; ++j) v[j] = (half_t)siluf(a[j] + aux[col + j]);
      *(h4*)(smem + (row * TS + col) * 2) = v;
    }
    __syncthreads();
    {
      const half_t* tl = (const half_t*)smem;
      const int l32 = lane & 31, hf = lane >> 5;
      f32x16 a2[2];
#pragma unroll
      for (int mt = 0; mt < 2; ++mt)
#pragma unroll
        for (int i = 0; i < 16; ++i) a2[mt][i] = 0.f;
#pragma unroll 4
      for (int s = 0; s < 16; ++s) {
        h8 b = *(const h8*)(tl + (32 * wid + l32) * TS + 16 * s + 8 * hf);
        h8 w0 = *(const h8*)(g.w2t + (l32) * 256 + 16 * s + 8 * hf);
        h8 w1 = *(const h8*)(g.w2t + (32 + l32) * 256 + 16 * s + 8 * hf);
        a2[0] = mfma32(w0, b, a2[0]); a2[1] = mfma32(w1, b, a2[1]);
      }
      const int ci = 32 * wid + l32; const int bgi = pm;
      if (g.kv == 0) {
        float ss = 0.f;
#pragma unroll
        for (int mt = 0; mt < 2; ++mt)
#pragma unroll
          for (int i = 0; i < 16; ++i) ss += a2[mt][i] * a2[mt][i];
        ss += __shfl_xor(ss, 32);
        float rr = rsqrtf(ss * (1.f / 64.f) + EPS);
#pragma unroll
        for (int mt = 0; mt < 2; ++mt)
#pragma unroll
          for (int r = 0; r < 4; ++r) {
            int d0 = 32 * mt + 8 * r + 4 * hf; h4 v;
#pragma unroll
            for (int i = 0; i < 4; ++i) v[i] = (half_t)(a2[mt][4 * r + i] * rr * g.kg0[d0 + i]);
            *(h4*)(g.kc + ((size_t)bgi * 256 + ci) * 64 + d0) = v;
          }
      } else {
#pragma unroll
        for (int mt = 0; mt < 2; ++mt)
#pragma unroll
          for (int rg = 0; rg < 16; ++rg) {
            int d = 32 * mt + crow(rg, hf);
            g.vct[((size_t)(bgi * 4 + (ci >> 6)) * 64 + d) * 64 + (ci & 63)] = (half_t)a2[mt][rg];
          }
      }
    }
  }
  __syncthreads();
}

DI void tile_decode(int t, int nM, int nN, int& pm, int& pn) {
  int per = 16 * nN; int sr = t / per; int rem = t - sr * per;
  int width = nM - sr * 16; if (width > 16) width = 16;
  pn = rem / width; pm = sr * 16 + rem % width;
}

template <int EPI>
__device__ void gemm_phase(const GArgs& g, char* smem) {
  int nt = g.nM * g.nN;
  for (int t = blockIdx.x; t < nt; t += gridDim.x) { int pm, pn; tile_decode(t, g.nM, g.nN, pm, pn); gemm_tile<EPI>(g, pm, pn, smem); }
}

__device__ void phase_prep(const Params& p, int l, char* smem) {
  char* ws = p.ws;
  half_t* proj = (half_t*)(ws + WS_PROJ);
  half_t* kcr = (half_t*)(ws + WS_KCR); half_t* vcr = (half_t*)(ws + WS_VCR);
  half_t* vst = (half_t*)(ws + WS_VST); half_t* vwt = (half_t*)(ws + WS_VWT);
  const float* cs = (const float*)(ws + WS_COS); const float* sn = (const float*)(ws + WS_SIN);
  const int tid = ltid();
  half_t* tl = (half_t*)smem;
  for (int it = blockIdx.x; it < 512; it += gridDim.x) {
    int b = it >> 6, blk = it & 63; long m0 = (long)b * T_ + blk * 64;
    {
      int tok = tid >> 3, sub = tid & 7; long m = m0 + tok; int t = blk * 64 + tok;
      float c8[8], s8[8];
      if (sub < 2) {
#pragma unroll
        for (int i = 0; i < 8; ++i) { c8[i] = cs[m * 8 + i]; s8[i] = sn[m * 8 + i]; }
      }
      h8 uv[14];
#pragma unroll
      for (int u = 0; u < 14; ++u) {
        int col = (u < 8) ? u * 64 : (u < 10 ? 1024 + (u - 8) * 64 : (u < 12 ? 1024 + 256 + (u - 10) * 64 : 1024 + 512 + (u - 12) * 64));
        uv[u] = *(const h8*)(proj + m * PL + col + sub * 8);
      }
      float gq[8], gs[8], gw[8];
#pragma unroll
      for (int i = 0; i < 8; ++i) { gq[i] = p.q_norm[l * 64 + sub * 8 + i]; gs[i] = p.k_norm[(l * 3 + 1) * 64 + sub * 8 + i]; gw[i] = p.k_norm[(l * 3 + 2) * 64 + sub * 8 + i]; }
#pragma unroll
      for (int u = 0; u < 14; ++u) {
        int col = (u < 8) ? u * 64 : (u < 10 ? 1024 + (u - 8) * 64 : (u < 12 ? 1024 + 256 + (u - 10) * 64 : 1024 + 512 + (u - 12) * 64));
        const bool norm = !(u == 8 || u == 9);
        const float scale = (u < 8) ? 0.125f * 1.4426950408889634f : 1.f;
        h8 v = uv[u]; float f[8]; float ss = 0.f;
#pragma unroll
        for (int i = 0; i < 8; ++i) { f[i] = (float)v[i]; ss += f[i] * f[i]; }
        if (norm) {
          ss += __shfl_xor(ss, 1); ss += __shfl_xor(ss, 2); ss += __shfl_xor(ss, 4);
          float r = rsqrtf(ss * (1.f / 64.f) + EPS);
#pragma unroll
          for (int i = 0; i < 8; ++i) f[i] = f[i] * r * (u < 8 ? gq[i] : (u < 12 ? gs[i] : gw[i]));
        }
        float o[8];
#pragma unroll
        for (int i = 0; i < 8; ++i) {
          float other = __shfl_xor(f[i], 1);
          o[i] = f[i];
          if (sub == 0) o[i] = f[i] * c8[i] - other * s8[i];
          else if (sub == 1) o[i] = f[i] * c8[i] + other * s8[i];
          o[i] *= scale;
        }
        h8 w;
#pragma unroll
        for (int i = 0; i < 8; ++i) w[i] = (half_t)o[i];
        if (u == 8 || u == 9) { int g = u - 8; *(h8*)(kcr + ((size_t)(b * 2 + g) * T_ + t) * 64 + sub * 8) = w; }
        else *(h8*)(proj + m * PL + col + sub * 8) = w;
      }
    }
#pragma unroll
    for (int e = 0; e < 2; ++e) {
      int id = tid + NTH * e; int tok = id >> 4, g = (id >> 3) & 1, c8i = id & 7;
      h8 v = *(const h8*)(proj + (m0 + tok) * PL + 1024 + 128 + g * 64 + c8i * 8);
      *(h8*)(vcr + ((size_t)(b * 2 + g) * T_ + blk * 64 + tok) * 64 + c8i * 8) = v;
    }
#pragma unroll 1
    for (int q = 0; q < 4; ++q) {
      int g = q & 1; int col = 1024 + (q < 2 ? 256 : 512) + 128 + g * 64;
      half_t* dst = (q < 2 ? vst : vwt) + ((size_t)((b * 2 + g) * 64 + blk)) * 4096;
      __syncthreads();
      { int tok = tid >> 3, c8i = tid & 7; h8 v = *(const h8*)(proj + (m0 + tok) * PL + col + c8i * 8);
#pragma unroll
        for (int i = 0; i < 8; ++i) tl[tok * 66 + c8i * 8 + i] = v[i]; }
      __syncthreads();
      { int d = tid >> 3, kc = tid & 7; h8 v;
#pragma unroll
        for (int i = 0; i < 8; ++i) v[i] = tl[(kc * 8 + i) * 66 + d];
        *(h8*)(dst + d * 64 + kc * 8) = v; }
    }
    __syncthreads();
  }
}

__device__ void gdn_pre_item(const Params& p, int l, int item, char* smem) {
  char* ws = p.ws;
  const half_t* proj = (const half_t*)(ws + WS_PROJ);
  half_t* WG = (half_t*)p.out; half_t* QG = WG + (size_t)M_ * 512; half_t* UG = QG + (size_t)M_ * 512;
  half_t* KTG = UG + (size_t)M_ * 512; half_t* AQK = (half_t*)(ws + WS_AQK); float* GL = (float*)(ws + WS_GL);
  int tid_ = threadIdx.x; asm volatile("" : "+v"(tid_));
  const int tid = tid_, wid = tid >> 6, lane = tid & 63;
  const int bh = item >> 6, n = item & 63, b = bh >> 2, h = bh & 3;
  const int cid = item; const long m0 = (long)b * T_ + n * 64;
  constexpr int RS = 392;
  half_t* raw = (half_t*)smem;
  float* Akk = (float*)smem; half_t* Th = (half_t*)(smem + 16384); half_t* KtT = (half_t*)(smem + 25600);
  float* TL = (float*)(smem + 44032);
  half_t* Kn = (half_t*)(smem + 61440);
  half_t* Qn = (half_t*)(smem + 78848);
  half_t* Vn = (half_t*)(smem + 96256);
  half_t* VbT = (half_t*)(smem + 113664);
  half_t* KbgT = (half_t*)(smem + 132096);
  float* gv = (float*)(smem + 150528);
  float* gcum = gv; float* beta = gv + 64;

  {
    h8 rv[7];
#pragma unroll
    for (int e = 0; e < 7; ++e) {
      int id = tid + NTH * e; int rr = id / 48, ch = id % 48; int arr = ch >> 4, c8i = ch & 15;
      int t = n * 64 - 3 + rr;
      rv[e] = h8{0, 0, 0, 0, 0, 0, 0, 0};
      if (id < 67 * 48 && t >= 0) rv[e] = *(const h8*)(proj + ((long)b * T_ + t) * PL + 1792 + arr * 512 + h * 128 + c8i * 8);
    }
#pragma unroll
    for (int e = 0; e < 7; ++e) {
      int id = tid + NTH * e; int rr = id / 48, ch = id % 48; int arr = ch >> 4, c8i = ch & 15;
      if (id < 67 * 48) *(h8*)(raw + rr * RS + arr * 128 + c8i * 8) = rv[e];
    }
  }
  if (wid == 0) {
    float a = (float)proj[(m0 + lane) * PL + 3352 + h], bb = (float)proj[(m0 + lane) * PL + 3356 + h];
    float xx = a + p.gdn_dt_bias[l * 4 + h];
    float ey = __expf(-fabsf(xx));
    float l1p = ey < 0.01f ? ey * (1.f - ey * (0.5f - ey * (1.f / 3.f))) : __logf(1.f + ey);
    float sp = fmaxf(xx, 0.f) + l1p;
    float gval = -expf(p.gdn_a_log[l * 4 + h]) * sp;
#pragma unroll
    for (int o = 1; o < 64; o <<= 1) { float y = __shfl_up(gval, o); if (lane >= o) gval += y; }
    gcum[lane] = gval; beta[lane] = sigm(bb);
  }
  __syncthreads();
  const int r = tid >> 3, sub = tid & 7;
  {
    const float* cw = p.gdn_conv_w + (size_t)l * 4 * 1536;
#pragma unroll 1
    for (int arr = 0; arr < 3; ++arr) {
      float y[16]; float ss = 0.f;
#pragma unroll
      for (int e2 = 0; e2 < 16; ++e2) y[e2] = 0.f;
#pragma unroll
      for (int j = 0; j < 4; ++j) {
        const half_t* xr = raw + (r + j) * RS + arr * 128 + sub * 16;
        h8 x0 = *(const h8*)xr, x1 = *(const h8*)(xr + 8);
        const float* wp = cw + j * 1536 + arr * 512 + h * 128 + sub * 16;
        float4 w0 = *(const float4*)wp, w1 = *(const float4*)(wp + 4), w2 = *(const float4*)(wp + 8), w3 = *(const float4*)(wp + 12);
        y[0] += w0.x * (float)x0[0]; y[1] += w0.y * (float)x0[1]; y[2] += w0.z * (float)x0[2]; y[3] += w0.w * (float)x0[3];
        y[4] += w1.x * (float)x0[4]; y[5] += w1.y * (float)x0[5]; y[6] += w1.z * (float)x0[6]; y[7] += w1.w * (float)x0[7];
        y[8] += w2.x * (float)x1[0]; y[9] += w2.y * (float)x1[1]; y[10] += w2.z * (float)x1[2]; y[11] += w2.w * (float)x1[3];
        y[12] += w3.x * (float)x1[4]; y[13] += w3.y * (float)x1[5]; y[14] += w3.z * (float)x1[6]; y[15] += w3.w * (float)x1[7];
      }
#pragma unroll
      for (int e2 = 0; e2 < 16; ++e2) { float a = silu_fast(y[e2]); y[e2] = a; ss += a * a; }
      ss += __shfl_xor(ss, 1); ss += __shfl_xor(ss, 2); ss += __shfl_xor(ss, 4);
      float sc = (arr == 0) ? rsqrtf(ss + EPS) * 0.08838834764831845f : (arr == 1 ? rsqrtf(ss + EPS) : 1.f);
      half_t* dst = (arr == 0) ? Qn : (arr == 1 ? Kn : Vn);
      h8 o0, o1;
#pragma unroll
      for (int e2 = 0; e2 < 8; ++e2) { o0[e2] = (half_t)(y[e2] * sc); o1[e2] = (half_t)(y[8 + e2] * sc); }
      *(h8*)(dst + r * 136 + sub * 16) = o0; *(h8*)(dst + r * 136 + sub * 16 + 8) = o1;
    }
  }
  __syncthreads();
  {
    float gc = gcum[r], bt = beta[r], gl = gcum[63];
    float eg = expf(gc), ek = expf(gl - gc);
    h8 q0, q1;
    h8 kv8[2], vv8[2], qv8[2];
    kv8[0] = *(const h8*)(Kn + r * 136 + sub * 16); kv8[1] = *(const h8*)(Kn + r * 136 + sub * 16 + 8);
    vv8[0] = *(const h8*)(Vn + r * 136 + sub * 16); vv8[1] = *(const h8*)(Vn + r * 136 + sub * 16 + 8);
    qv8[0] = *(const h8*)(Qn + r * 136 + sub * 16); qv8[1] = *(const h8*)(Qn + r * 136 + sub * 16 + 8);
#pragma unroll
    for (int e = 0; e < 16; ++e) {
      int d = sub * 16 + e;
      float kk = (float)kv8[e >> 3][e & 7], vv = (float)vv8[e >> 3][e & 7], qq = (float)qv8[e >> 3][e & 7];
      KbgT[d * 72 + r] = (half_t)(kk * bt * eg);
      VbT[d * 72 + r] = (half_t)(vv * bt);
      KtT[d * 72 + r] = (half_t)(kk * ek);
      half_t qv = (half_t)(qq * eg);
      if (e < 8) q0[e] = qv; else q1[e - 8] = qv;
    }
    *(h8*)(QG + (m0 + r) * 512 + h * 128 + sub * 16) = q0;
    *(h8*)(QG + (m0 + r) * 512 + h * 128 + sub * 16 + 8) = q1;
    if (tid == 0) GL[cid] = expf(gl);
  }
  __syncthreads();
  {
    const int which = wid >> 2, ti = (wid >> 1) & 1, tj = wid & 1, l32 = lane & 31, hf = lane >> 5;
    const half_t* Am = which ? Qn : Kn;
    f32x16 acc;
#pragma unroll
    for (int i = 0; i < 16; ++i) acc[i] = 0.f;
#pragma unroll
    for (int s = 0; s < 8; ++s) {
      h8 a = *(const h8*)(Am + (32 * ti + l32) * 136 + 16 * s + 8 * hf);
      h8 bb = *(const h8*)(Kn + (32 * tj + l32) * 136 + 16 * s + 8 * hf);
      acc = mfma32(a, bb, acc);
    }
    int j = 32 * tj + l32; float gj = gcum[j];
#pragma unroll
    for (int rg = 0; rg < 16; ++rg) {
      int i = 32 * ti + crow(rg, hf); float gi = gcum[i];
      if (which == 0) { float v = (j < i) ? beta[i] * acc[rg] * expf(gi - gj) : 0.f; Akk[i * 64 + j] = v; }
      else { float v = (j <= i) ? acc[rg] * expf(gi - gj) : 0.f; AQK[(size_t)cid * 4096 + i * 64 + j] = (half_t)v; }
    }
#pragma unroll
    for (int e = 0; e < 2; ++e) { int id = tid + NTH * e; int row = id >> 3, c8i = id & 7;
      *(h8*)(KTG + (size_t)cid * 8192 + row * 64 + c8i * 8) = *(const h8*)(KtT + row * 72 + c8i * 8); }
  }
  __syncthreads();
  float* Dg = TL + 64 * 65;
  float* RB = Dg + 1024;
  if (wid == 0) {
    const int blk = lane >> 4, cc = lane & 15;
    float x[16];
#pragma unroll
    for (int ii = 0; ii < 16; ++ii) {
      const float* ar = Akk + (16 * blk + ii) * 64 + 16 * blk;
      f32x4 a0 = *(const f32x4*)ar, a1 = *(const f32x4*)(ar + 4), a2 = *(const f32x4*)(ar + 8), a3 = *(const f32x4*)(ar + 12);
      float av[16] = {a0[0], a0[1], a0[2], a0[3], a1[0], a1[1], a1[2], a1[3], a2[0], a2[1], a2[2], a2[3], a3[0], a3[1], a3[2], a3[3]};
      float a = (ii == cc) ? 1.f : 0.f;
#pragma unroll
      for (int jj = 0; jj < ii; ++jj) a -= av[jj] * x[jj];
      x[ii] = a;
    }
#pragma unroll
    for (int ii = 0; ii < 16; ++ii) Dg[(blk * 16 + ii) * 16 + cc] = x[ii];
  }
  __syncthreads();
#pragma unroll 1
  for (int I = 0; I < 4; ++I) {
    const int il = tid >> 5, c0 = (tid & 31) * 2; const int i = 16 * I + il;
    {
      float a0 = (i == c0) ? 1.f : 0.f, a1 = (i == c0 + 1) ? 1.f : 0.f;
      for (int j = 0; j < 16 * I; ++j) { float av = Akk[i * 64 + j]; a0 -= av * TL[j * 65 + c0]; a1 -= av * TL[j * 65 + c0 + 1]; }
      RB[il * 65 + c0] = a0; RB[il * 65 + c0 + 1] = a1;
    }
    __syncthreads();
    {
      float t0 = 0.f, t1 = 0.f;
#pragma unroll
      for (int k = 0; k < 16; ++k) { float dv = Dg[(I * 16 + il) * 16 + k]; t0 += dv * RB[k * 65 + c0]; t1 += dv * RB[k * 65 + c0 + 1]; }
      TL[i * 65 + c0] = t0; TL[i * 65 + c0 + 1] = t1;
      Th[i * 72 + c0] = (half_t)t0; Th[i * 72 + c0 + 1] = (half_t)t1;
    }
    __syncthreads();
  }
  {
    const int ti = wid >> 2, tj = wid & 3, l32 = lane & 31, hf = lane >> 5;
    f32x16 au, aw;
#pragma unroll
    for (int i = 0; i < 16; ++i) { au[i] = 0.f; aw[i] = 0.f; }
#pragma unroll
    for (int s = 0; s < 4; ++s) {
      h8 a = *(const h8*)(Th + (32 * ti + l32) * 72 + 16 * s + 8 * hf);
      h8 bu = *(const h8*)(VbT + (32 * tj + l32) * 72 + 16 * s + 8 * hf);
      h8 bw = *(const h8*)(KbgT + (32 * tj + l32) * 72 + 16 * s + 8 * hf);
      au = mfma32(a, bu, au); aw = mfma32(a, bw, aw);
    }
#pragma unroll
    for (int rg = 0; rg < 16; ++rg) {
      int i = 32 * ti + crow(rg, hf); int dv = 32 * tj + l32;
      UG[(m0 + i) * 512 + h * 128 + dv] = (half_t)au[rg];
      WG[(m0 + i) * 512 + h * 128 + dv] = (half_t)aw[rg];
    }
  }
  __syncthreads();
}

__device__ void phase_cmp2(const Params& p, int l, char* smem) {
  char* ws = p.ws;
  const half_t* hid = (const half_t*)(ws + WS_HID);
  half_t* KC = (half_t*)(ws + WS_KC); half_t* VCT = (half_t*)(ws + WS_VCT);
  const int tid = ltid();
  half_t* hl = (half_t*)smem;
  float* w2 = (float*)(smem + 64 * 264 * 2);
  for (int it = blockIdx.x; it < 128; it += gridDim.x) {
    int kv = it >> 6, bg = (it >> 2) & 15, Tt = it & 3;
    const half_t* src = hid + ((size_t)kv * 4096 + bg * 256 + Tt * 64) * 256;
#pragma unroll
    for (int e = 0; e < 4; ++e) { int id = tid + NTH * e; int row = id >> 5, c16 = id & 31; *(h8*)(hl + row * 264 + c16 * 8) = *(const h8*)(src + row * 256 + c16 * 8); }
    const float* w2g = p.cmp_w2 + (size_t)(l * 2 + kv) * 256 * 64;
#pragma unroll
    for (int e = 0; e < 8; ++e) { int id = tid + NTH * e; *(float4*)(w2 + id * 4) = *(const float4*)(w2g + id * 4); }
    __syncthreads();
    int r = tid >> 3, dg = tid & 7; float acc[8];
#pragma unroll
    for (int i = 0; i < 8; ++i) acc[i] = 0.f;
    for (int k = 0; k < 256; ++k) {
      float hv = (float)hl[r * 264 + k];
      float4 wa = *(const float4*)(w2 + k * 64 + dg * 8), wb = *(const float4*)(w2 + k * 64 + dg * 8 + 4);
      acc[0] += hv * wa.x; acc[1] += hv * wa.y; acc[2] += hv * wa.z; acc[3] += hv * wa.w;
      acc[4] += hv * wb.x; acc[5] += hv * wb.y; acc[6] += hv * wb.z; acc[7] += hv * wb.w;
    }
    if (kv == 0) {
      float ss = 0.f;
#pragma unroll
      for (int i = 0; i < 8; ++i) ss += acc[i] * acc[i];
      ss += __shfl_xor(ss, 1); ss += __shfl_xor(ss, 2); ss += __shfl_xor(ss, 4);
      float rr = rsqrtf(ss * (1.f / 64.f) + EPS);
      h8 v;
#pragma unroll
      for (int i = 0; i < 8; ++i) v[i] = (half_t)(acc[i] * rr * p.k_norm[(l * 3 + 0) * 64 + dg * 8 + i]);
      *(h8*)(KC + ((size_t)bg * 256 + Tt * 64 + r) * 64 + dg * 8) = v;
    } else {
#pragma unroll
      for (int i = 0; i < 8; ++i) VCT[((size_t)(bg * 4 + Tt) * 64 + dg * 8 + i) * 64 + r] = (half_t)acc[i];
    }
    __syncthreads();
  }
}

constexpr int KVS = 72;
struct NsaCtx {
  const half_t* proj; const half_t* KC; const half_t* VCT; const half_t* VST; const half_t* VWT;
  int b, g, qb, bg; int tq; int l32, hf; int tid;
};

template <int MODE>
DI void nsa_branch(const NsaCtx& c, char* smem, int& bufsel, const h8 (&qf)[4], const float shift, float& l_run, f32x16 (&ot)[2],
                   float (&imp)[32], const unsigned* selmask_q, const unsigned* unionmask) {
  const int tid = c.tid;
  const int l32 = c.l32, hf = c.hf;
  const int ql = c.tq & 63;
  int cilim = (c.tq - 31) >> 4; if (cilim > 254) cilim = 254;
  unsigned um0 = 0, um1 = 0, sm0 = 0, sm1 = 0;
  if (MODE == 2) { um0 = unionmask[0]; um1 = unionmask[1]; sm0 = selmask_q[0]; sm1 = selmask_q[1]; }
  int jlo, jhi;
  if (MODE <= 1) { int cnt = 4 * c.qb + 3; if (cnt > 255) cnt = 255; jlo = 0; jhi = (cnt + 63) / 64 - 1; }
  else if (MODE == 2) { jlo = 0; jhi = c.qb; }
  else { jlo = c.qb - 8 < 0 ? 0 : c.qb - 8; jhi = c.qb; }
  auto next_tile = [&](int j) -> int {
    ++j;
    if (MODE == 2) { while (j <= jhi && !(((j < 32 ? um0 >> j : um1 >> (j - 32)) & 1u))) ++j; }
    return j <= jhi ? j : -1;
  };
  h8 kreg[2], vreg[2];
  auto load_regs = [&](int j, h8& kr, h8& vr) {
    int row = tid >> 3, c8i = tid & 7;
    if (MODE <= 1) {
      kr = *(const h8*)(c.KC + ((size_t)c.bg * 256 + j * 64 + row) * 64 + c8i * 8);
      if (MODE == 1) vr = *(const h8*)(c.VCT + (size_t)(c.bg * 4 + j) * 4096 + tid * 8);
    } else {
      int col = 1024 + (MODE == 2 ? 256 : 512) + c.g * 64;
      kr = *(const h8*)(c.proj + ((size_t)c.b * T_ + j * 64 + row) * PL + col + c8i * 8);
      vr = *(const h8*)((MODE == 2 ? c.VST : c.VWT) + (size_t)(c.bg * 64 + j) * 4096 + tid * 8);
    }
  };
  float ylast = 0.f;
  auto compute = [&](int j, const half_t* K, const half_t* V) {
    bool selj = true;
    if (MODE == 2) selj = ((j < 32 ? sm0 >> j : sm1 >> (j - 32)) & 1u) != 0;
    const float init = selj ? -shift : -INFINITY;
    bool need_mask; int lim = 63, lo = 0;
    if (MODE <= 1) { need_mask = true; lim = cilim - 64 * j; }
    else if (MODE == 2) { need_mask = (j == c.qb); lim = ql; }
    else { need_mask = (j == c.qb) || (j == c.qb - 8); if (j == c.qb) lim = ql; else lo = ql + 1; }
    float ps = 0.f;
#pragma unroll
    for (int kt = 0; kt < 2; ++kt) {
      f32x16 st;
      {
        h8 kf[4];
#pragma unroll
        for (int s = 0; s < 4; ++s) kf[s] = *(const h8*)(K + (32 * kt + l32) * KVS + 16 * s + 8 * hf);
#pragma unroll
        for (int i = 0; i < 16; ++i) st[i] = init;
#pragma unroll
        for (int s = 0; s < 4; ++s) st = mfma32(kf[s], qf[s], st);
        __builtin_amdgcn_sched_group_barrier(0x100, 4, 0);
        __builtin_amdgcn_sched_group_barrier(0x008, 4, 0);
      }
      if (need_mask) {
        asm volatile("; boundary tile mask" ::: );
#pragma unroll
        for (int rg = 0; rg < 16; ++rg) {
          int key = 32 * kt + crow(rg, hf);
          st[rg] = (key <= lim && key >= lo) ? st[rg] : -INFINITY;
        }
      }
#pragma unroll
      for (int rg = 0; rg < 16; ++rg) { float pv = EXP2(st[rg]); st[rg] = pv; ps += pv; }
      if (MODE == 1) {
        float y[4];
#pragma unroll
        for (int r = 0; r < 4; ++r) y[r] = __shfl_xor(st[4 * r + 3], 32);
#pragma unroll
        for (int r = 0; r < 4; ++r) {
          float own = st[4 * r] + st[4 * r + 1] + st[4 * r + 2] + st[4 * r + 3];
          float prev = (r > 0) ? y[r - 1] : ylast;
          float carry = hf ? y[r] : prev;
          float add = own + carry;
#pragma unroll
          for (int Tt = 0; Tt < 4; ++Tt) imp[Tt * 8 + kt * 4 + r] += (j == Tt) ? add : 0.f;
        }
        ylast = y[3];
      }
      h8 pf[2];
#pragma unroll
      for (int s2 = 0; s2 < 2; ++s2)
#pragma unroll
        for (int i2 = 0; i2 < 4; ++i2) {
          h2 pr = __builtin_bit_cast(h2, __builtin_amdgcn_cvt_pkrtz(st[8 * s2 + 2 * i2], st[8 * s2 + 2 * i2 + 1]));
          pf[s2][2 * i2] = pr[0]; pf[s2][2 * i2 + 1] = pr[1];
        }
      {
        h8 vf[2][2];
#pragma unroll
        for (int dt = 0; dt < 2; ++dt)
#pragma unroll
          for (int s2 = 0; s2 < 2; ++s2) {
            h4 v0 = *(const h4*)(V + (32 * dt + l32) * KVS + 32 * kt + 16 * s2 + 4 * hf);
            h4 v1 = *(const h4*)(V + (32 * dt + l32) * KVS + 32 * kt + 16 * s2 + 8 + 4 * hf);
            vf[dt][s2] = cat44(v0, v1);
          }
#pragma unroll
        for (int s2 = 0; s2 < 2; ++s2)
#pragma unroll
          for (int dt = 0; dt < 2; ++dt) ot[dt] = mfma32(vf[dt][s2], pf[s2], ot[dt]);
      }
    }
    l_run += ps;
  };
  int ja = next_tile(jlo - 1);
  int jb = ja >= 0 ? next_tile(ja) : -1;
  if (ja >= 0) load_regs(ja, kreg[0], vreg[0]);
  if (jb >= 0) load_regs(jb, kreg[1], vreg[1]);
  while (ja >= 0) {
    char* sb = smem + bufsel * 36864;
    { int row = tid >> 3, c8i = tid & 7;
      *(h8*)((half_t*)(sb) + row * KVS + c8i * 8) = kreg[0];
      if (MODE != 0) *(h8*)((half_t*)(sb + 18432) + row * KVS + c8i * 8) = vreg[0];
      if (jb >= 0) {
        *(h8*)((half_t*)(sb + 9216) + row * KVS + c8i * 8) = kreg[1];
        if (MODE != 0) *(h8*)((half_t*)(sb + 27648) + row * KVS + c8i * 8) = vreg[1];
      } }
    __syncthreads();
    int jc = jb >= 0 ? next_tile(jb) : -1;
    int jd = jc >= 0 ? next_tile(jc) : -1;
    if (jc >= 0) load_regs(jc, kreg[0], vreg[0]);
    if (jd >= 0) load_regs(jd, kreg[1], vreg[1]);
    compute(ja, (const half_t*)sb, (const half_t*)(sb + 18432));
    if (jb >= 0) compute(jb, (const half_t*)(sb + 9216), (const half_t*)(sb + 27648));
    bufsel ^= 1; ja = jc; jb = jd;
  }
}

__device__ void nsa_item(const Params& p, int l, int item, char* smem, int dry = 0) {
  char* ws = p.ws;
  half_t* proj = (half_t*)(ws + WS_PROJ);
  int tid_ = threadIdx.x; asm volatile("" : "+v"(tid_));
  const int tid = tid_, wid = tid >> 6, lane = tid & 63;
  NsaCtx c; c.tid = tid;
  c.proj = proj; c.KC = (const half_t*)(ws + WS_KC); c.VCT = (const half_t*)(ws + WS_VCT);
  c.VST = (const half_t*)(ws + WS_VST); c.VWT = (const half_t*)(ws + WS_VWT);
  c.qb = 63 - (item >> 4); c.bg = item & 15; c.b = c.bg >> 1; c.g = c.bg & 1;
  c.l32 = lane & 31; c.hf = lane >> 5;
  const int hp = wid >> 1, qhalf = wid & 1, h = c.g * 4 + hp;
  const int ql = 32 * qhalf + c.l32;
  c.tq = c.qb * 64 + ql;
  const long mq = (long)c.b * T_ + c.tq;
  float* impbuf = (float*)(smem + 73728);
  float* seltot = (float*)(smem + 73728 + 65536);
  unsigned* selmask = (unsigned*)(smem + 73728 + 65536 + 16384);
  unsigned* unionmask = selmask + 128;
  h8 qf[4];
#pragma unroll
  for (int s = 0; s < 4; ++s) qf[s] = *(const h8*)(proj + mq * PL + h * 64 + 16 * s + 8 * c.hf);
  float gate[3];
#pragma unroll
  for (int br = 0; br < 3; ++br) gate[br] = sigm((float)proj[mq * PL + 3328 + h * 3 + br]);
  f32x16 outacc[2], ot[2];
#pragma unroll
  for (int dt = 0; dt < 2; ++dt)
#pragma unroll
    for (int i = 0; i < 16; ++i) { outacc[dt][i] = 0.f; ot[dt][i] = 0.f; }
  float imp[32];
#pragma unroll
  for (int i = 0; i < 32; ++i) imp[i] = 0.f;
  int bufsel = 0;
  if (tid < 130) selmask[tid] = 0u;
  float shiftv[3];
  {
    float gq = fabsf(p.q_norm[l * 64 + lane]);
    float g0 = fabsf(p.k_norm[(l * 3 + 0) * 64 + lane]), g1 = fabsf(p.k_norm[(l * 3 + 1) * 64 + lane]), g2 = fabsf(p.k_norm[(l * 3 + 2) * 64 + lane]);
#pragma unroll
    for (int o = 32; o >= 1; o >>= 1) { gq = fmaxf(gq, __shfl_xor(gq, o)); g0 = fmaxf(g0, __shfl_xor(g0, o)); g1 = fmaxf(g1, __shfl_xor(g1, o)); g2 = fmaxf(g2, __shfl_xor(g2, o)); }
    shiftv[0] = fmaxf(0.f, 11.5416f * gq * g0 - 14.f); shiftv[1] = fmaxf(0.f, 11.5416f * gq * g1 - 14.f); shiftv[2] = fmaxf(0.f, 11.5416f * gq * g2 - 14.f);
  }
  float l_run = 0.f;
  nsa_branch<1>(c, smem, bufsel, qf, shiftv[0], l_run, ot, imp, nullptr, nullptr);
  { float lt = l_run + __shfl_xor(l_run, 32); float inv = lt > 0.f ? 1.f / lt : 0.f;
#pragma unroll
    for (int dt = 0; dt < 2; ++dt)
#pragma unroll
      for (int i = 0; i < 16; ++i) { outacc[dt][i] += gate[0] * inv * ot[dt][i]; ot[dt][i] = 0.f; }
#pragma unroll
    for (int i = 0; i < 32; ++i) {
      int Tt = i >> 3, kt = (i >> 2) & 1, r = i & 3;
      impbuf[(hp * 64 + ql) * 64 + 16 * Tt + 8 * kt + 2 * r + c.hf] = imp[i] * inv;
    } }
  __syncthreads();
  {
    int q = tid >> 3, sub = tid & 7; int cur = c.qb;
#pragma unroll
    for (int k = 0; k < 8; ++k) {
      int j = sub + 8 * k;
      float v = impbuf[(0 * 64 + q) * 64 + j] + impbuf[(1 * 64 + q) * 64 + j] + impbuf[(2 * 64 + q) * 64 + j] + impbuf[(3 * 64 + q) * 64 + j];
      if (j == 0 || j == cur || j == cur - 1) v = INFINITY;
      else if (j > cur) v = -INFINITY;
      seltot[q * 64 + j] = v;
    }
  }
  __syncthreads();
  {
    int q = tid >> 3, sub = tid & 7;
    float mine[8]; int rank[8];
#pragma unroll
    for (int k = 0; k < 8; ++k) { mine[k] = seltot[q * 64 + sub + 8 * k]; rank[k] = 0; }
    for (int jj = 0; jj < 64; ++jj) {
      float o = seltot[q * 64 + jj];
#pragma unroll
      for (int k = 0; k < 8; ++k) { int j = sub + 8 * k; rank[k] += (o > mine[k] || (o == mine[k] && jj < j)) ? 1 : 0; }
    }
    unsigned b0 = 0, b1 = 0;
#pragma unroll
    for (int k = 0; k < 8; ++k) { int j = sub + 8 * k; if (rank[k] < 16) { if (j < 32) b0 |= 1u << j; else b1 |= 1u << (j - 32); } }
    if (b0) { atomicOr(&selmask[q * 2], b0); atomicOr(&unionmask[0], b0); }
    if (b1) { atomicOr(&selmask[q * 2 + 1], b1); atomicOr(&unionmask[1], b1); }
  }
  __syncthreads();
  l_run = 0.f;
  nsa_branch<2>(c, smem, bufsel, qf, shiftv[1], l_run, ot, imp, selmask + ql * 2, unionmask);
  { float lt = l_run + __shfl_xor(l_run, 32); float inv = lt > 0.f ? 1.f / lt : 0.f;
#pragma unroll
    for (int dt = 0; dt < 2; ++dt)
#pragma unroll
      for (int i = 0; i < 16; ++i) { outacc[dt][i] += gate[1] * inv * ot[dt][i]; ot[dt][i] = 0.f; } }
  l_run = 0.f;
  nsa_branch<3>(c, smem, bufsel, qf, shiftv[2], l_run, ot, imp, nullptr, nullptr);
  { float lt = l_run + __shfl_xor(l_run, 32); float inv = lt > 0.f ? 1.f / lt : 0.f;
#pragma unroll
    for (int dt = 0; dt < 2; ++dt)
#pragma unroll
      for (int i = 0; i < 16; ++i) outacc[dt][i] += gate[2] * inv * ot[dt][i]; }
  float ss = 0.f;
#pragma unroll
  for (int dt = 0; dt < 2; ++dt)
#pragma unroll
    for (int i = 0; i < 16; ++i) ss += outacc[dt][i] * outacc[dt][i];
  ss += __shfl_xor(ss, 32);
  float rr = rsqrtf(ss * (1.f / 64.f) + EPS);
  int t2 = tid; asm volatile("" : "+v"(t2));
  const int h2 = c.g * 4 + (t2 >> 7);
  const long mq2 = (long)c.b * T_ + c.qb * 64 + 32 * ((t2 >> 6) & 1) + (t2 & 31);
  const float* og = p.nsa_out_norm + (size_t)(l * 8 + h2) * 64;
#pragma unroll
  for (int dt = 0; dt < 2; ++dt)
#pragma unroll
    for (int r = 0; r < 4; ++r) {
      int d0 = 32 * dt + 8 * r + 4 * c.hf; h4 v;
#pragma unroll
      for (int i = 0; i < 4; ++i) v[i] = (half_t)(outacc[dt][4 * r + i] * rr * og[d0 + i]);
      *(h4*)(proj + mq2 * PL + (dry ? 2304 : 0) + h2 * 64 + d0) = v;
    }
  __syncthreads();
}

__device__ void gdn_scan_item(const Params& p, int l, int bh, char* smem, int dry = 0) {
  char* ws = p.ws;
  half_t* proj = (half_t*)(ws + WS_PROJ);
  const half_t* WG = (const half_t*)p.out; const half_t* QG = WG + (size_t)M_ * 512; const half_t* UG = QG + (size_t)M_ * 512;
  const half_t* KTG = UG + (size_t)M_ * 512; const half_t* AQK = (const half_t*)(ws + WS_AQK); const float* GL = (const float*)(ws + WS_GL);
  int tid_ = threadIdx.x; asm volatile("" : "+v"(tid_));
  const int tid = tid_, wid = tid >> 6, lane = tid & 63, l16 = lane & 15, quad = lane >> 4;
  const int b = bh >> 2, h = bh & 3;
  half_t* Wl = (half_t*)smem;
  half_t* Ql = (half_t*)(smem + 17408);
  half_t* Al = (half_t*)(smem + 34816);
  half_t* Ktl = (half_t*)(smem + 44032);
  half_t* Ul = (half_t*)(smem + 62464);
  float* ost = (float*)(smem + 79872);
  f32x4 St[8];
#pragma unroll
  for (int i = 0; i < 8; ++i) St[i] = f32x4{0.f, 0.f, 0.f, 0.f};
  h8 rw[2], rq[2], ru[2], rk[2], ra, rz[2], zc[2];
  auto prefetch = [&](int n) {
    long m0 = (long)b * T_ + n * 64; size_t cid = (size_t)bh * 64 + n;
    { const half_t* zp0 = proj + (m0 + (tid >> 3)) * PL + 512 + h * 128 + (tid & 7) * 16; rz[0] = *(const h8*)zp0; rz[1] = *(const h8*)(zp0 + 8); }
#pragma unroll
    for (int e = 0; e < 2; ++e) {
      int id = tid + NTH * e; int row = id >> 4, c16 = id & 15;
      rw[e] = *(const h8*)(WG + (m0 + row) * 512 + h * 128 + c16 * 8);
      rq[e] = *(const h8*)(QG + (m0 + row) * 512 + h * 128 + c16 * 8);
      ru[e] = *(const h8*)(UG + (m0 + row) * 512 + h * 128 + c16 * 8);
      rk[e] = *(const h8*)(KTG + cid * 8192 + id * 8);
    }
    ra = *(const h8*)(AQK + cid * 4096 + tid * 8);
  };
  prefetch(0);
  const float* og = p.gdn_out_norm + l * 128;
  for (int n = 0; n < 64; ++n) {
#pragma unroll
    for (int e = 0; e < 2; ++e) {
      int id = tid + NTH * e; int row = id >> 4, c16 = id & 15;
      *(h8*)(Wl + row * 136 + c16 * 8) = rw[e];
      *(h8*)(Ql + row * 136 + c16 * 8) = rq[e];
      *(h8*)(Ul + row * 136 + c16 * 8) = ru[e];
      int krow = id >> 3, kc = id & 7;
      *(h8*)(Ktl + krow * 72 + kc * 8) = rk[e];
    }
    { int row = tid >> 3, kc = tid & 7; *(h8*)(Al + row * 72 + kc * 8) = ra; }
    zc[0] = rz[0]; zc[1] = rz[1];
    int zoff = 0; asm volatile("" : "+v"(zoff));
    const float egl = GL[(size_t)bh * 64 + n + zoff];
    __syncthreads();
    if (n + 1 < 64) prefetch(n + 1);
    h8 Sf[4];
#pragma unroll
    for (int s = 0; s < 4; ++s)
#pragma unroll
      for (int i = 0; i < 4; ++i) { Sf[s][i] = (half_t)St[2 * s][i]; Sf[s][4 + i] = (half_t)St[2 * s + 1][i]; }
#define SCHEDB __builtin_amdgcn_sched_barrier(0)
    f32x4 vn[4];
    {
      h8 fa[16]; float uu[16];
#pragma unroll
      for (int ct = 0; ct < 4; ++ct)
#pragma unroll
        for (int s = 0; s < 4; ++s) {
          h4 w0 = *(const h4*)(Wl + (16 * ct + l16) * 136 + 32 * s + 4 * quad);
          h4 w1 = *(const h4*)(Wl + (16 * ct + l16) * 136 + 32 * s + 16 + 4 * quad);
          fa[ct * 4 + s] = cat44(w0, w1);
        }
#pragma unroll
      for (int ct = 0; ct < 4; ++ct)
#pragma unroll
        for (int i = 0; i < 4; ++i) uu[ct * 4 + i] = (float)Ul[(16 * ct + 4 * quad + i) * 136 + 16 * wid + l16];
      SCHEDB;
      {
        f32x4 aa[4];
#pragma unroll
        for (int ct = 0; ct < 4; ++ct) aa[ct] = f32x4{0.f, 0.f, 0.f, 0.f};
#pragma unroll
        for (int s = 0; s < 4; ++s)
#pragma unroll
          for (int ct = 0; ct < 4; ++ct) aa[ct] = mfma16(fa[ct * 4 + s], Sf[s], aa[ct]);
#pragma unroll
        for (int ct = 0; ct < 4; ++ct)
#pragma unroll
          for (int i = 0; i < 4; ++i) vn[ct][i] = uu[ct * 4 + i] - aa[ct][i];
      }
      SCHEDB;
    }
    h8 Vf[2];
#pragma unroll
    for (int s = 0; s < 2; ++s)
#pragma unroll
      for (int i = 0; i < 4; ++i) { Vf[s][i] = (half_t)vn[2 * s][i]; Vf[s][4 + i] = (half_t)vn[2 * s + 1][i]; }
    f32x4 oacc[4];
    {
      h8 fq[16];
#pragma unroll
      for (int ct = 0; ct < 4; ++ct)
#pragma unroll
        for (int s = 0; s < 4; ++s) {
          h4 q0 = *(const h4*)(Ql + (16 * ct + l16) * 136 + 32 * s + 4 * quad);
          h4 q1 = *(const h4*)(Ql + (16 * ct + l16) * 136 + 32 * s + 16 + 4 * quad);
          fq[ct * 4 + s] = cat44(q0, q1);
        }
      SCHEDB;
#pragma unroll
      for (int ct = 0; ct < 4; ++ct) oacc[ct] = f32x4{0.f, 0.f, 0.f, 0.f};
#pragma unroll
      for (int s = 0; s < 4; ++s)
#pragma unroll
        for (int ct = 0; ct < 4; ++ct) oacc[ct] = mfma16(fq[ct * 4 + s], Sf[s], oacc[ct]);
      SCHEDB;
    }
    {
      h8 fb[8];
#pragma unroll
      for (int ct = 0; ct < 4; ++ct)
#pragma unroll
        for (int s = 0; s < 2; ++s) {
          h4 a0 = *(const h4*)(Al + (16 * ct + l16) * 72 + 32 * s + 4 * quad);
          h4 a1 = *(const h4*)(Al + (16 * ct + l16) * 72 + 32 * s + 16 + 4 * quad);
          fb[ct * 2 + s] = cat44(a0, a1);
        }
      SCHEDB;
#pragma unroll
      for (int s = 0; s < 2; ++s)
#pragma unroll
        for (int ct = 0; ct < 4; ++ct) oacc[ct] = mfma16(fb[ct * 2 + s], Vf[s], oacc[ct]);
#pragma unroll
      for (int ct = 0; ct < 4; ++ct)
#pragma unroll
        for (int i = 0; i < 4; ++i) ost[(16 * ct + 4 * quad + i) * 132 + 16 * wid + l16] = oacc[ct][i];
      SCHEDB;
    }
    {
      h8 fk[16];
#pragma unroll
      for (int Tt = 0; Tt < 8; ++Tt)
#pragma unroll
        for (int s = 0; s < 2; ++s) {
          h4 k0 = *(const h4*)(Ktl + (16 * Tt + l16) * 72 + 32 * s + 4 * quad);
          h4 k1 = *(const h4*)(Ktl + (16 * Tt + l16) * 72 + 32 * s + 16 + 4 * quad);
          fk[Tt * 2 + s] = cat44(k0, k1);
        }
      SCHEDB;
#pragma unroll
      for (int Tt = 0; Tt < 8; ++Tt) St[Tt] = St[Tt] * egl;
#pragma unroll
      for (int s = 0; s < 2; ++s)
#pragma unroll
        for (int Tt = 0; Tt < 8; ++Tt) St[Tt] = mfma16(fk[Tt * 2 + s], Vf[s], St[Tt]);
      SCHEDB;
    }
    __syncthreads();
    {
      int r = tid >> 3, seg = tid & 7; long m = (long)b * T_ + n * 64 + r;
      float o[16]; float ss = 0.f;
#pragma unroll
      for (int e = 0; e < 16; ++e) { o[e] = ost[r * 132 + seg * 16 + e]; ss += o[e] * o[e]; }
      ss += __shfl_xor(ss, 1); ss += __shfl_xor(ss, 2); ss += __shfl_xor(ss, 4);
      float rr = rsqrtf(ss * (1.f / 128.f) + EPS);
      half_t* zp = proj + m * PL + 512 + h * 128 + seg * 16;
      h8 z0 = zc[0], z1 = zc[1], o0, o1;
#pragma unroll
      for (int e = 0; e < 8; ++e) {
        o0[e] = (half_t)(o[e] * rr * og[seg * 16 + e] * silu_fast((float)z0[e]));
        o1[e] = (half_t)(o[8 + e] * rr * og[seg * 16 + 8 + e] * silu_fast((float)z1[e]));
      }
      half_t* op = dry ? zp + (1792 - 512) : zp;
      *(h8*)op = o0; *(h8*)(op + 8) = o1;
    }
  }
  __syncthreads();
}

#define XB_TMO      128
#define XB_XCNT(j)  (256  + 64 * (j))
#define XB_XSUB(j)  (1280 + 64 * (j))
#define XB_XGEN(j)  (2304 + 64 * (j))
#define XB_TOP      3328
#define XB_TOPGEN   3392
#define XCD_BAR_WORDS 3456
#define XB_SPIN_CAP (1u << 18)
#define LAS __attribute__((address_space(3)))

__device__ __forceinline__ unsigned xb_ld(unsigned* p)              { return __hip_atomic_load(p, __ATOMIC_RELAXED, __HIP_MEMORY_SCOPE_AGENT); }
__device__ __forceinline__ unsigned xb_add(unsigned* p, unsigned v) { return __hip_atomic_fetch_add(p, v, __ATOMIC_RELAXED, __HIP_MEMORY_SCOPE_AGENT); }
__device__ __forceinline__ unsigned xb_xcc_id() { return (unsigned)__builtin_amdgcn_s_getreg((3 << 11) | 20) & 0xFu; }
#define XB_SPIN(cond, bar) do { unsigned _sp = 0; while (cond) { __builtin_amdgcn_s_sleep(1); \
    if ((++_sp & 255u) == 0u) { if (xb_ld(&(bar)[XB_TMO])) break; if (_sp > XB_SPIN_CAP) { atomicAdd(&(bar)[XB_TMO], 1u); break; } } } } while (0)

struct XcdBarrier {
    unsigned* bar; unsigned x;
    volatile LAS unsigned* st;
};

__device__ __forceinline__ XcdBarrier xcd_barrier_post(unsigned* bar, volatile LAS unsigned* st) {
    XcdBarrier b; b.bar = bar; b.x = xb_xcc_id(); b.st = st;
    if (threadIdx.x == 0) (void)xb_add(&bar[XB_XCNT(b.x)], 1u);
    return b;
}
__device__ __forceinline__ void xcd_barrier_complete(unsigned* bar, unsigned x, unsigned& nloc, unsigned& nx) {
    const unsigned G = gridDim.x * gridDim.y * gridDim.z;
    unsigned sum, cnt, mine, sp = 0u;
    for (;;) {
        sum = 0u; cnt = 0u; mine = 0u;
#pragma unroll
        for (unsigned j = 0; j < 16; ++j) { const unsigned c = xb_ld(&bar[XB_XCNT(j)]); sum += c; cnt += (c > 0u) ? 1u : 0u; mine = (j == x) ? c : mine; }
        if (sum == G) break;
        __builtin_amdgcn_s_sleep(1);
        if ((++sp & 255u) == 0u) { if (xb_ld(&bar[XB_TMO])) break; if (sp > XB_SPIN_CAP) { atomicAdd(&bar[XB_TMO], 1u); break; } }
    }
    nloc = mine > 0u ? mine : 1u; nx = cnt > 0u ? cnt : 1u;
}

__device__ __forceinline__ void xcd_barrier(const XcdBarrier& b) {
    asm volatile("s_waitcnt vmcnt(0)" ::: "memory");
    __syncthreads();
    if (threadIdx.x == 0) {
        unsigned* bar = b.bar;
        __builtin_amdgcn_s_waitcnt(0);
        unsigned nloc = b.st[0], nx = b.st[1];
        if (nloc == 0u) { xcd_barrier_complete(bar, b.x, nloc, nx); b.st[0] = nloc; b.st[1] = nx; }
        const unsigned old = xb_add(&bar[XB_XSUB(b.x)], 1u);
        const unsigned gen = old / nloc;
        if (old + 1u == (gen + 1u) * nloc) {
            __builtin_amdgcn_fence(__ATOMIC_RELEASE, "agent");
            asm volatile("s_waitcnt vmcnt(0)" ::: "memory");
            const unsigned og = xb_add(&bar[XB_TOP], 1u);
            const unsigned tg = og / nx;
            if (og + 1u == (tg + 1u) * nx) xb_add(&bar[XB_TOPGEN], 1u);
            else XB_SPIN(xb_ld(&bar[XB_TOPGEN]) == tg, bar);
            __builtin_amdgcn_fence(__ATOMIC_ACQUIRE, "agent");
            xb_add(&bar[XB_XGEN(b.x)], 1u);
            asm volatile("s_waitcnt vmcnt(0)" ::: "memory");
        } else {
            XB_SPIN(xb_ld(&bar[XB_XGEN(b.x)]) == gen, bar);
            __builtin_amdgcn_fence(__ATOMIC_ACQUIRE, "agent");
            asm volatile("s_waitcnt vmcnt(0)" ::: "memory");
        }
    }
    __syncthreads();
}


DI void grid_barrier(unsigned* cnt, unsigned target) {
  asm volatile("s_waitcnt vmcnt(0) lgkmcnt(0)" ::: "memory");
  __syncthreads();
  if (threadIdx.x == 0) {
    __builtin_amdgcn_fence(__ATOMIC_RELEASE, "agent");
    asm volatile("s_waitcnt vmcnt(0)" ::: "memory");
    __hip_atomic_fetch_add(cnt, 1u, __ATOMIC_RELAXED, __HIP_MEMORY_SCOPE_AGENT);
    while (__hip_atomic_load(cnt, __ATOMIC_RELAXED, __HIP_MEMORY_SCOPE_AGENT) < target) __builtin_amdgcn_s_sleep(1);
    __builtin_amdgcn_fence(__ATOMIC_ACQUIRE, "agent");
    asm volatile("s_waitcnt vmcnt(0) lgkmcnt(0)" ::: "memory");
  }
  __syncthreads();
}

__global__ void __launch_bounds__(NTH, 2) fwd_mega(Params p) {
  extern __shared__ __attribute__((aligned(16))) char smem[];
  cg::grid_group grid = cg::this_grid();
#ifndef PROBE_K
#define PROBE_K -1
#endif
#ifndef PROBE_K2
#define PROBE_K2 -1
#endif
  bool first = true; int repflag = 0; int nbar = 0;
  char* const ws_base = p.ws;
  volatile LAS unsigned* xst = (volatile LAS unsigned*)(smem + LDS_BYTES - 16);
  if (threadIdx.x < 4) xst[threadIdx.x] = 0u;
  __syncthreads();
  XcdBarrier xb = xcd_barrier_post((unsigned*)(p.ws + WS_END), xst);
  for (int ph = p.phase_lo; ph < p.phase_hi;) {
    if (ph % 9 == 2 || ph % 9 == 4 || (ph % 9 == 0 && ph > 0)) { ++ph; continue; }
    if (!first) {
      if (nbar == 0) grid.sync();
      else xcd_barrier(xb);
      ++nbar;
    }
    first = false;
    const int ph_cur = ph;
    {
      const int kk = ph % 9;
      if ((kk == PROBE_K || kk == PROBE_K2) && !repflag && (PROBE_K != 6 || ph < 9)) { repflag = 1; }
      else if (PROBE_K == 15 && kk == 5 && !repflag) { repflag = 1; ph -= 4; }
      else { if (PROBE_K != 15 || kk == 5) repflag = 0; ++ph; }
    }
    { size_t zoffs = 0; asm volatile("" : "+s"(zoffs)); p.ws = ws_base + zoffs; }
    char* ws = p.ws;
    const int l = ph_cur / 9, k = ph_cur % 9;
    if (k == 0) {
      for (int ll = 0; ll < 4; ++ll) phase_weights(p, ll, smem);
    } else if (k == 1) {
      GArgs g{}; g.A = (const half_t*)(ws + WS_XH + 8192); g.lda = 1024; g.Bt = (const half_t*)(ws + wset(l) + WS_WIN); g.K = 1024; g.nM = 128; g.nN = 14;
      g.rss = (const float*)(ws + WS_RSS); g.outh = (half_t*)(ws + WS_PROJ); g.ldo = PL;
      g.cs = (const float*)(ws + WS_COS); g.sn = (const float*)(ws + WS_SIN); g.qg = p.q_norm + l * 64;
      g.kg1 = p.k_norm + (l * 3 + 1) * 64; g.kg2 = p.k_norm + (l * 3 + 2) * 64;
      g.kcr = (half_t*)(ws + WS_KCR); g.vcr = (half_t*)(ws + WS_VCR); g.vst = (half_t*)(ws + WS_VST); g.vwt = (half_t*)(ws + WS_VWT);
      gemm_phase<EPI_IN>(g, smem);
    } else if (k == 3) {
      GArgs g{}; g.lda = 1024; g.K = 2048; g.nM = 16; g.nN = 1; g.ldo = 256;
      for (int it = blockIdx.x; it < 32; it += gridDim.x) {
        int kv = it >> 4, pm = it & 15;
        g.A = (const half_t*)(ws + (kv ? WS_VCR : WS_KCR)); g.Bt = (const half_t*)(ws + wset(l) + WS_WC1) + (size_t)kv * 256 * 2048;
        g.c1p = (const float*)(ws + wset(l) + WS_C1P) + kv * 256; g.kv = kv;
        g.w2t = (const half_t*)(ws + w2t_off(l)) + (size_t)kv * 64 * 256; g.kc = (half_t*)(ws + WS_KC); g.vct = (half_t*)(ws + WS_VCT); g.kg0 = p.k_norm + (l * 3 + 0) * 64;
        gemm_tile<EPI_CMP>(g, pm, 0, smem);
      }
#ifndef NOGDN
      if (blockIdx.x < 32) { for (int it = blockIdx.x * 6; it < blockIdx.x * 6 + 6; ++it) gdn_pre_item(p, l, it, smem); }
      else { for (int it = 192 + (blockIdx.x - 32); it < 2048; it += gridDim.x - 32) gdn_pre_item(p, l, it, smem); }
#endif
    } else if (k == 5) {
#ifndef PROBE_DRY
#define PROBE_DRY 0
#endif
      for (int pass = (PROBE_DRY ? 0 : 1); pass < 2; ++pass) {
        const int dry = (pass == 0);
        if (pass == 1 && PROBE_DRY) grid.sync();
        if (blockIdx.x < 32) { if (!dry || PROBE_DRY == 1) gdn_scan_item(p, l, blockIdx.x, smem, dry); }
        else if (!dry || PROBE_DRY == 2) {
          const int nb = gridDim.x - 32, bi = blockIdx.x - 32;
          for (int r = 0; r * nb < 1024; ++r) { int it = r * nb + ((r & 1) ? nb - 1 - bi : bi); if (it < 1024) nsa_item(p, l, it, smem, dry); }
        }
      }
    } else if (k == 6) {
      GArgs g{}; g.A = (const half_t*)(ws + WS_PROJ); g.lda = PL; g.Bt = (const half_t*)(ws + wset(l) + WS_WOUT); g.K = 1024; g.nM = 128; g.nN = 4;
      g.xout = nullptr; g.rss_out = (float*)(ws + WS_RSS);
      g.outh = (half_t*)(ws + WS_XH + 8192); g.ldo = 1024;
      gemm_phase<EPI_RES>(g, smem);
    } else if (k == 7) {
      GArgs g{}; g.A = (const half_t*)(ws + WS_XH + 8192); g.lda = 1024; g.Bt = (const half_t*)(ws + wset(l) + WS_WUP); g.K = 1024; g.nM = 128; g.nN = 22;
      g.hf = (half_t*)(ws + WS_HF); g.hl = (half_t*)(ws + WS_HL);
      g.rss = (const float*)(ws + WS_RSS); g.outh = (half_t*)(ws + WS_PROJ); g.ldo = NFF;
      g.convw = p.ffn_conv_w + (size_t)l * 3 * 5632; g.convb = p.ffn_conv_b + (size_t)l * 5632;
      gemm_phase<EPI_UP>(g, smem);
    } else {
      GArgs g{}; g.A = (const half_t*)(ws + WS_PROJ); g.lda = NFF; g.Bt = (const half_t*)(ws + wset(l) + WS_WDOWN); g.K = 2816; g.nM = 128; g.nN = 4;
      g.hf = (half_t*)(ws + WS_HF); g.hl = (half_t*)(ws + WS_HL); g.convw = p.ffn_conv_w + (size_t)l * 3 * 5632; g.convb = p.ffn_conv_b + (size_t)l * 5632;
      g.xout = (l < 3) ? nullptr : p.out; g.rss_out = (float*)(ws + WS_RSS);
      g.outh = (half_t*)(ws + WS_XH + 8192); g.ldo = 1024;
      gemm_phase<EPI_RES>(g, smem);
    }
  }
}

extern "C" void kernel_launch(void* const* d_in, const int* in_sizes, int n_in, void* d_out, int out_size, void* d_ws, size_t ws_size,
                              hipStream_t stream) {
  static int grid_blocks = 0;
  if (!grid_blocks) {
    if (ws_size < WS_END + XCD_BAR_WORDS * 4) { fprintf(stderr, "kernel_launch: workspace too small: %zu < %zu\n", ws_size, (size_t)WS_END); grid_blocks = -1; }
    else {
      int dev = 0, cus = 0, per_cu = 0;
      hipGetDevice(&dev);
      hipDeviceGetAttribute(&cus, hipDeviceAttributeMultiprocessorCount, dev);
      hipFuncSetAttribute((const void*)fwd_mega, hipFuncAttributeMaxDynamicSharedMemorySize, LDS_BYTES);
      hipOccupancyMaxActiveBlocksPerMultiprocessor(&per_cu, fwd_mega, NTH, LDS_BYTES);
      if (per_cu < 1) per_cu = 1;
      grid_blocks = cus < 64 ? -1 : cus;
    }
  }
  if (grid_blocks <= 0) return;
  Params p{};
  p.x = (const float*)d_in[0]; p.pos = (const int*)d_in[1]; p.attn_norm = (const float*)d_in[2]; p.w_in = (const float*)d_in[3];
  p.q_norm = (const float*)d_in[4]; p.k_norm = (const float*)d_in[5]; p.cmp_pe = (const float*)d_in[6]; p.cmp_w1 = (const float*)d_in[7];
  p.cmp_w2 = (const float*)d_in[8]; p.nsa_out_norm = (const float*)d_in[9]; p.gdn_conv_w = (const float*)d_in[10];
  p.gdn_a_log = (const float*)d_in[11]; p.gdn_dt_bias = (const float*)d_in[12]; p.gdn_out_norm = (const float*)d_in[13];
  p.w_out = (const float*)d_in[14]; p.ffn_norm = (const float*)d_in[15]; p.w_up = (const float*)d_in[16]; p.ffn_conv_w = (const float*)d_in[17];
  p.ffn_conv_b = (const float*)d_in[18]; p.w_down = (const float*)d_in[19];
  p.out = (float*)d_out; p.ws = (char*)d_ws; p.phase_lo = 0; p.phase_hi = 36;
  (void)hipMemsetAsync((char*)d_ws + WS_END, 0, XCD_BAR_WORDS * 4, stream);
  void* args[] = {&p};
  hipError_t e = hipLaunchCooperativeKernel((void*)fwd_mega, dim3(grid_blocks), dim3(NTH), args, LDS_BYTES, stream);
  if (e != hipSuccess) fprintf(stderr, "cooperative launch failed: %s (grid %d)\n", hipGetErrorString(e), grid_blocks);
}
```

```cpp
#include <hip/hip_runtime.h>
#include <hip/hip_cooperative_groups.h>
#include <cstdio>
#include <cstdint>
namespace cg = cooperative_groups;

typedef _Float16 half_t;
typedef _Float16 h8 __attribute__((ext_vector_type(8)));
typedef _Float16 h4 __attribute__((ext_vector_type(4)));
typedef float f32x4 __attribute__((ext_vector_type(4)));
typedef float f32x16 __attribute__((ext_vector_type(16)));
#define DI __device__ __forceinline__

constexpr int M_ = 32768, T_ = 4096, D_ = 1024, PL = 3584, NFF = 2816;
constexpr int NTH = 512;
constexpr int LDS_BYTES = 163840;
constexpr float EPS = 1e-6f;

constexpr size_t AL(size_t x) { return (x + 255) & ~(size_t)255; }
constexpr size_t WS_WIN = 0;
constexpr size_t WS_WOUT = WS_WIN + AL((size_t)PL * 1024 * 2);
constexpr size_t WS_WUP = WS_WOUT + AL((size_t)1024 * 1024 * 2);
constexpr size_t WS_WDOWN = WS_WUP + AL((size_t)5632 * 1024 * 2);
constexpr size_t WS_WC1 = WS_WDOWN + AL((size_t)1024 * 2816 * 2);
constexpr size_t WS_C1P = WS_WC1 + AL((size_t)2 * 256 * 2048 * 2);
constexpr size_t WS_COS = WS_C1P + AL((size_t)16 * 512 * 4);
constexpr size_t WS_SIN = WS_COS + AL((size_t)M_ * 8 * 4);
constexpr size_t WS_RSS = WS_SIN + AL((size_t)M_ * 8 * 4);
constexpr size_t WS_XH = WS_RSS + AL((size_t)M_ * 4 * 4);
constexpr size_t WS_PROJ = WS_XH + AL((size_t)(M_ + 264) * 1024 * 2);
constexpr size_t WS_KCR = WS_PROJ + AL((size_t)M_ * PL * 2);
constexpr size_t WS_VCR = WS_KCR + AL(((size_t)16 * 4096 * 64 + 4096) * 2);
constexpr size_t WS_HID = WS_VCR + AL(((size_t)16 * 4096 * 64 + 4096) * 2);
constexpr size_t WS_KC = WS_HID + AL((size_t)2 * 4096 * 256 * 2);
constexpr size_t WS_VCT = WS_KC + AL((size_t)16 * 256 * 64 * 2);
constexpr size_t WS_VST = WS_VCT + AL((size_t)16 * 256 * 64 * 2);
constexpr size_t WS_VWT = WS_VST + AL((size_t)16 * 64 * 4096 * 2);
constexpr size_t WS_WG = WS_VWT + AL((size_t)16 * 64 * 4096 * 2);
constexpr size_t WS_QG = WS_WG + AL((size_t)M_ * 512 * 2);
constexpr size_t WS_UG = WS_QG + AL((size_t)M_ * 512 * 2);
constexpr size_t WS_KTG = WS_UG + AL((size_t)M_ * 512 * 2);
constexpr size_t WS_AQK = WS_KTG + AL((size_t)2048 * 128 * 64 * 2);
constexpr size_t WS_GL = WS_AQK + AL((size_t)2048 * 64 * 64 * 2);
constexpr size_t WS_END = WS_GL + AL((size_t)2048 * 4);

__constant__ float ROPE_INV[8] = {1.000000000e+00f,1.939227432e-01f,3.760603070e-02f,7.292664610e-03f,1.414213562e-03f,2.742481884e-04f,5.318295734e-05f,1.031338525e-05f};

constexpr size_t WSET_STRIDE = AL(WS_COS + 65536);
constexpr size_t WS_HF = WS_WG + 4 * WSET_STRIDE;
constexpr size_t WS_HL = WS_HF + AL((size_t)128 * 2 * 5632 * 2);
constexpr size_t WS_KST = WS_HL + AL((size_t)128 * 2 * 5632 * 2);
static_assert(WS_KST + (size_t)16 * 64 * 4096 * 2 <= WS_AQK, "halo / key-tile buffers must fit the free region");
DI size_t wset(int l) { return WS_WG + (size_t)l * WSET_STRIDE; }
DI size_t w2t_off(int l) { return WS_WG + (size_t)l * WSET_STRIDE + WS_COS; }

struct Params {
  const float* x; const int* pos; const float* attn_norm; const float* w_in; const float* q_norm; const float* k_norm;
  const float* cmp_pe; const float* cmp_w1; const float* cmp_w2; const float* nsa_out_norm; const float* gdn_conv_w;
  const float* gdn_a_log; const float* gdn_dt_bias; const float* gdn_out_norm; const float* w_out; const float* ffn_norm;
  const float* w_up; const float* ffn_conv_w; const float* ffn_conv_b; const float* w_down;
  float* out; char* ws; int phase_lo; int phase_hi;
};

DI float sigm(float x) { return 1.f / (1.f + expf(-x)); }
DI float siluf(float x) { return x / (1.f + expf(-x)); }
DI float silu_fast(float x) { return x * __frcp_rn(1.f + __expf(-x)); }
DI f32x16 mfma32(h8 a, h8 b, f32x16 c) { return __builtin_amdgcn_mfma_f32_32x32x16_f16(a, b, c, 0, 0, 0); }
DI f32x4 mfma16(h8 a, h8 b, f32x4 c) { return __builtin_amdgcn_mfma_f32_16x16x32_f16(a, b, c, 0, 0, 0); }
DI h8 cat44(h4 a, h4 b) { return __builtin_shufflevector(a, b, 0, 1, 2, 3, 4, 5, 6, 7); }
DI char* lws(const Params& p) { char* w = p.ws; asm volatile("" : "+s"(w)); return w; }
DI int ltid() { int t = threadIdx.x; asm volatile("" : "+v"(t)); return t; }
typedef _Float16 h2 __attribute__((ext_vector_type(2)));
#define EXP2(x) __builtin_amdgcn_exp2f(x)
DI int crow(int reg, int hf) { return (reg & 3) + 8 * (reg >> 2) + 4 * hf; }

DI int map_in(int c) {
  if (c < 512) return c;
  if (c < 1024) return 2848 + (c - 512);
  if (c < 1792) return 512 + (c - 1024);
  if (c < 3328) return 1304 + (c - 1792);
  if (c < 3352) return 1280 + (c - 3328);
  if (c < 3360) return 2840 + (c - 3352);
  return -1;
}
DI int map_up(int c) { int n = c >> 8, j = c & 255; return j < 128 ? n * 128 + j : 2816 + n * 128 + (j - 128); }

template <int MAP>
__device__ void conv_transpose(const float* __restrict__ W, int K, int No, half_t* __restrict__ Wt, int Np, char* smem, const float* __restrict__ rs = nullptr) {
  float* tile = (float*)smem;
  const int tid = ltid();
  const int ntn = Np / 64, ntk = K / 64;
  for (int t = blockIdx.x; t < ntn * ntk; t += gridDim.x) {
    int tn = t % ntn, tk = t / ntn;
#pragma unroll
    for (int e = 0; e < 8; ++e) {
      int idx = tid + NTH * e; int kk = idx >> 6, nn = idx & 63;
      int np = tn * 64 + nn;
      int on = MAP == 1 ? map_in(np) : (MAP == 2 ? map_up(np) : np);
      float v = on >= 0 ? W[(size_t)(tk * 64 + kk) * No + on] : 0.f;
      if (rs) v *= rs[tk * 64 + kk];
      tile[kk * 65 + nn] = v;
    }
    __syncthreads();
    {
      int nn = tid >> 3, kg = tid & 7; h8 v;
#pragma unroll
      for (int j = 0; j < 8; ++j) v[j] = (half_t)tile[(kg * 8 + j) * 65 + nn];
      *(h8*)(Wt + (size_t)(tn * 64 + nn) * K + tk * 64 + kg * 8) = v;
    }
    __syncthreads();
  }
}

__device__ void phase_weights(const Params& p, int l, char* smem) {
  char* ws = p.ws + wset(l);
  conv_transpose<1>(p.w_in + (size_t)l * 1024 * 3360, 1024, 3360, (half_t*)(ws + WS_WIN), PL, smem, p.attn_norm + l * 1024);
  conv_transpose<0>(p.w_out + (size_t)l * 1024 * 1024, 1024, 1024, (half_t*)(ws + WS_WOUT), 1024, smem);
  conv_transpose<2>(p.w_up + (size_t)l * 1024 * 5632, 1024, 5632, (half_t*)(ws + WS_WUP), 5632, smem, p.ffn_norm + l * 1024);
  conv_transpose<0>(p.w_down + (size_t)l * 2816 * 1024, 2816, 1024, (half_t*)(ws + WS_WDOWN), 1024, smem);
  for (int kv = 0; kv < 2; ++kv)
    conv_transpose<0>(p.cmp_w1 + (size_t)(l * 2 + kv) * 2048 * 256, 2048, 256, (half_t*)(ws + WS_WC1) + (size_t)kv * 256 * 2048, 256, smem);
  for (int kv = 0; kv < 2; ++kv)
    conv_transpose<0>(p.cmp_w2 + (size_t)(l * 2 + kv) * 256 * 64, 256, 64, (half_t*)(p.ws + w2t_off(l)) + (size_t)kv * 64 * 256, 64, smem);
  float* c1p = (float*)(ws + WS_C1P);
  for (int it = blockIdx.x; it < 32; it += gridDim.x) {
    int kv = it >> 4, kc = it & 15; int n = ltid();
    if (n < 256) {
      const float* pe = p.cmp_pe + (size_t)(l * 2 + kv) * 2048 + kc * 128;
      const float* w1 = p.cmp_w1 + ((size_t)(l * 2 + kv) * 2048 + kc * 128) * 256 + n;
      float s = 0.f;
      for (int k = 0; k < 128; ++k) s += pe[k] * w1[(size_t)k * 256];
      c1p[kc * 512 + kv * 256 + n] = s;
    }
  }
  if (l == 0) {
    half_t* xh = (half_t*)(p.ws + WS_XH + 8192); float* rss = (float*)(p.ws + WS_RSS);
    float* cs = (float*)(p.ws + WS_COS); float* sn = (float*)(p.ws + WS_SIN);
    const int tidw = ltid(); const int wid = tidw >> 6, lane = tidw & 63;
    for (int row = blockIdx.x * 8 + wid; row < M_; row += gridDim.x * 8) {
      const float* xr = p.x + (size_t)row * 1024;
      float ss = 0.f;
#pragma unroll
      for (int e = 0; e < 2; ++e) {
        int c = (e * 64 + lane) * 8;
        float4 a = *(const float4*)(xr + c), b = *(const float4*)(xr + c + 4);
        float4 ga = {1.f, 1.f, 1.f, 1.f}, gb = {1.f, 1.f, 1.f, 1.f};
        ss += a.x * a.x + a.y * a.y + a.z * a.z + a.w * a.w + b.x * b.x + b.y * b.y + b.z * b.z + b.w * b.w;
        h8 v; v[0] = (half_t)(a.x * ga.x); v[1] = (half_t)(a.y * ga.y); v[2] = (half_t)(a.z * ga.z); v[3] = (half_t)(a.w * ga.w);
        v[4] = (half_t)(b.x * gb.x); v[5] = (half_t)(b.y * gb.y); v[6] = (half_t)(b.z * gb.z); v[7] = (half_t)(b.w * gb.w);
        *(h8*)(xh + (size_t)row * 1024 + c) = v;
      }
#pragma unroll
      for (int o = 32; o >= 1; o >>= 1) ss += __shfl_xor(ss, o);
      if (lane == 0) { float4 r; r.x = ss; r.y = 0.f; r.z = 0.f; r.w = 0.f; *(float4*)(rss + (size_t)row * 4) = r; }
      if (lane < 8) {
        float inv = ROPE_INV[lane];
        float ang = (float)p.pos[row] * inv;
        cs[(size_t)row * 8 + lane] = cosf(ang);
        sn[(size_t)row * 8 + lane] = sinf(ang);
      }
    }
  }
}

DI int lds_byte(int r, int c) {
  int st = (r >> 4) * 2 + (c >> 5), rr = r & 15, cc = c & 31, ob = rr * 64 + cc * 2;
  return st * 1024 + (ob ^ (((ob >> 9) & 1) << 5));
}
DI void stage_rc(int b, int& R, int& C) {
  int st = b / 1024, sb = b % 1024, swz = sb ^ (((sb >> 9) & 1) << 5);
  R = (st >> 1) * 16 + swz / 64; C = (st & 1) * 32 + (swz % 64) / 2;
}

DI void gemm_kloop(const half_t* __restrict__ A0, const half_t* __restrict__ A1, const half_t* __restrict__ Bt0, const half_t* __restrict__ Bt1,
                   const unsigned (&oa)[2], const unsigned (&ob)[2], int nt, char* smem, f32x4 (&acc)[2][2][4][2], const int tid) {
  const int wid = tid >> 6, lane = tid & 63, wr = wid >> 2, wc = wid & 3, fr = lane & 15, fq = lane >> 4;
  constexpr int HTB = 128 * 64 * 2;
#define SA(b, h) (smem + ((b) * 2 + (h)) * HTB)
#define SB(b, h) (smem + (4 + (b) * 2 + (h)) * HTB)
#define STAGE(P, BASE, O, kt) do { for (int _i = 0; _i < 2; ++_i) { \
    __builtin_amdgcn_global_load_lds((const unsigned*)((BASE) + (long)(kt) * 64 + (O)[_i]), (unsigned*)((P) + tid * 16 + _i * 8192), 16, 0, 0); } } while (0)
#define LDA(dst, b, h) for (int m = 0; m < 4; ++m) for (int k = 0; k < 2; ++k) \
    dst[m][k] = *reinterpret_cast<const h8*>(SA(b, h) + lds_byte(wr * 64 + m * 16 + fr, k * 32 + fq * 8))
#define LDB(dst, b, h) for (int n = 0; n < 2; ++n) for (int k = 0; k < 2; ++k) \
    dst[n][k] = *reinterpret_cast<const h8*>(SB(b, h) + lds_byte(wc * 32 + n * 16 + fr, k * 32 + fq * 8))
#define MMA(ai, bj, At_, Bt_) do { __builtin_amdgcn_s_setprio(1); \
    for (int m = 0; m < 4; ++m) for (int n = 0; n < 2; ++n) for (int k = 0; k < 2; ++k) \
      acc[ai][bj][m][n] = mfma16(Bt_[n][k], At_[m][k], acc[ai][bj][m][n]); \
    __builtin_amdgcn_s_setprio(0); } while (0)
#define WAIT_V(n) asm volatile("s_waitcnt vmcnt(" #n ")" ::: "memory")
#define WAIT_L(n) asm volatile("s_waitcnt lgkmcnt(" #n ")" ::: "memory")
#define BAR __builtin_amdgcn_s_barrier()
#define SCHED __builtin_amdgcn_sched_barrier(0)
  h8 At[4][2], B0[2][2], B1[2][2];
#pragma unroll
  for (int a = 0; a < 2; ++a) for (int b = 0; b < 2; ++b) for (int m = 0; m < 4; ++m) for (int n = 0; n < 2; ++n) acc[a][b][m][n] = f32x4{0.f, 0.f, 0.f, 0.f};
  STAGE(SB(0, 0), Bt0, ob, 0); STAGE(SA(0, 0), A0, oa, 0);
  STAGE(SB(0, 1), Bt1, ob, 0); STAGE(SA(0, 1), A1, oa, 0);
  if (wr == 1) BAR;
  WAIT_V(4); BAR;
  STAGE(SB(1, 0), Bt0, ob, 1); STAGE(SA(1, 0), A0, oa, 1); STAGE(SB(1, 1), Bt1, ob, 1);
  WAIT_V(6); BAR;
  for (int t = 0; t < nt - 2; t += 2) {
    LDB(B0, 0, 0); SCHED; LDA(At, 0, 0); STAGE(SA(1, 1), A1, oa, t + 1);
    WAIT_L(8); BAR; WAIT_L(0); MMA(0, 0, At, B0); BAR; SCHED;
    LDB(B1, 0, 1); STAGE(SB(0, 0), Bt0, ob, t + 2);
    BAR; WAIT_L(0); MMA(0, 1, At, B1); BAR;
    LDA(At, 0, 1); STAGE(SA(0, 0), A0, oa, t + 2);
    BAR; WAIT_L(0); MMA(1, 0, At, B0); BAR; SCHED;
    STAGE(SB(0, 1), Bt1, ob, t + 2);
    WAIT_V(6); BAR; MMA(1, 1, At, B1); BAR;
    LDB(B0, 1, 0); SCHED; LDA(At, 1, 0); STAGE(SA(0, 1), A1, oa, t + 2);
    WAIT_L(8); BAR; WAIT_L(0); MMA(0, 0, At, B0); BAR; SCHED;
    LDB(B1, 1, 1); STAGE(SB(1, 0), Bt0, ob, t + 3);
    BAR; WAIT_L(0); MMA(0, 1, At, B1); BAR;
    LDA(At, 1, 1); STAGE(SA(1, 0), A0, oa, t + 3);
    BAR; WAIT_L(0); MMA(1, 0, At, B0); BAR; SCHED;
    STAGE(SB(1, 1), Bt1, ob, t + 3);
    WAIT_V(6); BAR; MMA(1, 1, At, B1); BAR;
  }
  { LDB(B0, 0, 0); LDA(At, 0, 0); STAGE(SA(1, 1), A1, oa, nt - 1);
    BAR; WAIT_L(0); MMA(0, 0, At, B0); BAR;
    LDB(B1, 0, 1); BAR; WAIT_L(0); MMA(0, 1, At, B1); BAR;
    LDA(At, 0, 1); WAIT_V(4); BAR; WAIT_L(0); MMA(1, 0, At, B0); MMA(1, 1, At, B1); BAR; }
  { LDB(B0, 1, 0); LDA(At, 1, 0); WAIT_V(2); BAR; WAIT_L(0); MMA(0, 0, At, B0); BAR;
    LDB(B1, 1, 1); WAIT_V(0); BAR; WAIT_L(0); MMA(0, 1, At, B1); BAR;
    LDA(At, 1, 1); BAR; WAIT_L(0); MMA(1, 0, At, B0); MMA(1, 1, At, B1); BAR; }
  if (wr == 0) BAR;
#undef SA
#undef SB
#undef STAGE
#undef LDA
#undef LDB
#undef MMA
#undef WAIT_V
#undef WAIT_L
#undef BAR
#undef SCHED
}

enum { EPI_IN = 0, EPI_RES = 1, EPI_UP = 2, EPI_CMP = 3 };
struct GArgs {
  const half_t* A; long lda; const half_t* Bt; int K; int nM; int nN;
  const float* rss; half_t* outh; long ldo;
  const float* resid; float* xout; const float* gain_next; float* rss_out;
  const float* convw; const float* convb; const float* c1p;
  const float* cs; const float* sn; const float* qg; const float* kg1; const float* kg2;
  half_t* kcr; half_t* vcr; half_t* vst; half_t* vwt;
  const half_t* w2t; half_t* kc; half_t* vct; const float* kg0; int kv;
  half_t* hf; half_t* hl; half_t* kst;
};

constexpr int TS = 264;

DI void tile_copy_out(const char* smem, half_t* out, long ldo, long grow0, int gcol0, int tid) {
#pragma unroll
  for (int e = 0; e < 16; ++e) {
    int id = tid + NTH * e; int row = id >> 5, c16 = id & 31;
    h8 v = *(const h8*)(smem + (row * TS + c16 * 8) * 2);
    *(h8*)(out + (grow0 + row) * ldo + gcol0 + c16 * 8) = v;
  }
}

template <int EPI>
__device__ void gemm_tile(const GArgs& g, int pm, int pn, char* smem) {
  int tid = ltid();
  const long brow = (long)pm * 256;
  const int bcol = pn * 256;
  if (EPI == EPI_RES) {
    if (g.convw && (pm & 15) != 0) {
      const half_t* L = g.hl + (size_t)(pm - 1) * 2 * 5632; const half_t* F = g.hf + (size_t)pm * 2 * 5632;
      for (int idx = tid; idx < 2816; idx += NTH) {
        int pnn = idx >> 7, cc = idx & 127; int gcol = pnn * 256 + cc, ucol = gcol + 128;
        float wg0 = g.convw[idx], wg1 = g.convw[5632 + idx], wg2 = g.convw[2 * 5632 + idx];
        float wu0 = g.convw[2816 + idx], wu1 = g.convw[5632 + 2816 + idx], wu2 = g.convw[2 * 5632 + 2816 + idx];
        float bgv = g.convb[idx], buv = g.convb[2816 + idx];
        float L0g = (float)L[gcol], L1g = (float)L[5632 + gcol], F0g = (float)F[gcol], F1g = (float)F[5632 + gcol];
        float L0u = (float)L[ucol], L1u = (float)L[5632 + ucol], F0u = (float)F[ucol], F1u = (float)F[5632 + ucol];
        float y0g = wg2 * F0g + wg1 * L1g + wg0 * L0g + bgv, y0u = wu2 * F0u + wu1 * L1u + wu0 * L0u + buv;
        float y1g = wg2 * F1g + wg1 * F0g + wg0 * L1g + bgv, y1u = wu2 * F1u + wu1 * F0u + wu0 * L1u + buv;
        half_t* act = (half_t*)g.A;
        act[brow * NFF + idx] = (half_t)(silu_fast(y0g) * y0u);
        act[(brow + 1) * NFF + idx] = (half_t)(silu_fast(y1g) * y1u);
      }
      asm volatile("s_waitcnt vmcnt(0)" ::: "memory");
      __syncthreads();
    }
  }
  unsigned oa[2], ob[2];
#pragma unroll
  for (int i = 0; i < 2; ++i) {
    int R, C; stage_rc(tid * 16 + i * 8192, R, C);
    oa[i] = (unsigned)(R * (int)g.lda + C);
    ob[i] = (unsigned)(R * g.K + C);
  }
  f32x4 acc[2][2][4][2];
  gemm_kloop(g.A + brow * g.lda, g.A + (brow + 128) * g.lda, g.Bt + (long)bcol * g.K, g.Bt + (long)(bcol + 128) * g.K, oa, ob, g.K / 64, smem, acc, tid);
  __syncthreads();
  asm volatile("" : "+v"(tid));
  const int wid = tid >> 6, lane = tid & 63, wr = wid >> 2, wc = wid & 3, fr = lane & 15, fq = lane >> 4;
  float* aux = (float*)(smem + 256 * TS * 2);

  if (EPI == EPI_IN || EPI == EPI_UP) {
    float rs[2][4];
#pragma unroll
    for (int ai = 0; ai < 2; ++ai)
#pragma unroll
      for (int m = 0; m < 4; ++m) {
        long gr = brow + ai * 128 + wr * 64 + m * 16 + fr;
        gr = gr < 0 ? 0 : (gr > M_ - 1 ? M_ - 1 : gr);
        float4 s4 = *(const float4*)(g.rss + gr * 4);
        rs[ai][m] = rsqrtf((s4.x + s4.y + s4.z + s4.w) * (1.f / 1024.f) + EPS);
      }
#pragma unroll
    for (int ai = 0; ai < 2; ++ai) for (int bj = 0; bj < 2; ++bj) for (int m = 0; m < 4; ++m) for (int n = 0; n < 2; ++n) {
      int row = ai * 128 + wr * 64 + m * 16 + fr, col = bj * 128 + wc * 32 + n * 16 + fq * 4;
      f32x4 a = acc[ai][bj][m][n]; float s = rs[ai][m];
      h4 v; v[0] = (half_t)(a[0] * s); v[1] = (half_t)(a[1] * s); v[2] = (half_t)(a[2] * s); v[3] = (half_t)(a[3] * s);
      *(h4*)(smem + (row * TS + col) * 2) = v;
    }
    __syncthreads();
    if (EPI == EPI_IN) {
      if (pn <= 1 || (pn >= 4 && pn <= 6)) {
        half_t* tl = (half_t*)smem;
        const int sub = tid & 7;
        const int bb = (int)(brow >> 12), t0 = (int)(brow & (T_ - 1));
        const int nu = (pn <= 1) ? 4 : 2;
        const float* gain = (pn <= 1) ? g.qg : (pn == 5 ? g.kg1 : (pn == 6 ? g.kg2 : nullptr));
        const float scale = (pn <= 1) ? 0.125f * 1.4426950408889634f : 1.f;
        float gn8[8];
#pragma unroll
        for (int i = 0; i < 8; ++i) gn8[i] = gain ? gain[sub * 8 + i] : 1.f;
#pragma unroll 1
        for (int it = 0; it < 4; ++it) {
          const int row = (tid >> 3) + 64 * it; const long m = brow + row;
          float c8[8], s8[8];
#pragma unroll
          for (int i = 0; i < 8; ++i) { c8[i] = 1.f; s8[i] = 0.f; }
          if (sub < 2) {
#pragma unroll
            for (int i = 0; i < 8; ++i) { c8[i] = g.cs[m * 8 + i]; s8[i] = g.sn[m * 8 + i]; }
          }
#pragma unroll 1
          for (int u = 0; u < nu; ++u) {
            half_t* src = tl + row * TS + u * 64 + sub * 8;
            h8 v = *(const h8*)src; float f[8]; float ss = 0.f;
#pragma unroll
            for (int i = 0; i < 8; ++i) { f[i] = (float)v[i]; ss += f[i] * f[i]; }
            ss += __shfl_xor(ss, 1); ss += __shfl_xor(ss, 2); ss += __shfl_xor(ss, 4);
            if (gain) {
              float r = rsqrtf(ss * (1.f / 64.f) + EPS);
#pragma unroll
              for (int i = 0; i < 8; ++i) f[i] = f[i] * r * gn8[i];
            }
            h8 w;
#pragma unroll
            for (int i = 0; i < 8; ++i) {
              float other = __shfl_xor(f[i], 1);
              float o = f[i];
              if (sub == 0) o = f[i] * c8[i] - other * s8[i];
              else if (sub == 1) o = f[i] * c8[i] + other * s8[i];
              w[i] = (half_t)(o * scale);
            }
            *(h8*)src = w;
            if (pn == 4) *(h8*)(g.kcr + ((size_t)(bb * 2 + u) * T_ + t0 + row) * 64 + sub * 8) = w;
          }
        }
        if (pn == 5) __syncthreads();
        if (pn == 4) {
#pragma unroll
          for (int e = 0; e < 8; ++e) {
            int id = tid + NTH * e; int row = id >> 4, gg = (id >> 3) & 1, c8i = id & 7;
            *(h8*)(g.vcr + ((size_t)(bb * 2 + gg) * T_ + t0 + row) * 64 + c8i * 8) = *(const h8*)(tl + row * TS + 128 + gg * 64 + c8i * 8);
          }
        } else if (pn >= 5) {
          if (pn == 5) {
            const int krow = tid >> 3, kc8 = tid & 7;
#pragma unroll 1
            for (int q = 0; q < 8; ++q) {
              int kb = q >> 1, gg = q & 1;
              *(h8*)(g.kst + ((size_t)((bb * 2 + gg) * 64 + (t0 >> 6) + kb)) * 4096 + krow * 64 + kc8 * 8) = *(const h8*)(tl + (kb * 64 + krow) * TS + gg * 64 + kc8 * 8);
            }
          }
          half_t* vdst = (pn == 5) ? g.vst : g.vwt;
          const int d = tid >> 3, kc = tid & 7;
#pragma unroll 1
          for (int q = 0; q < 8; ++q) {
            int kb = q >> 1, gg = q & 1; h8 v;
#pragma unroll
            for (int i = 0; i < 8; ++i) v[i] = tl[(kb * 64 + kc * 8 + i) * TS + 128 + gg * 64 + d];
            *(h8*)(vdst + ((size_t)((bb * 2 + gg) * 64 + (t0 >> 6) + kb)) * 4096 + d * 64 + kc * 8) = v;
          }
        }
        __syncthreads();
      }
      tile_copy_out(smem, g.outh, g.ldo, brow, bcol, tid);
    } else {
      const int cgp = tid & 15;
      const int gc = pn * 128 + cgp * 8;
      float wg[3][8], wu[3][8], bg[8], bu[8];
#pragma unroll
      for (int j = 0; j < 3; ++j)
#pragma unroll
        for (int e = 0; e < 8; ++e) { wg[j][e] = g.convw[j * 5632 + gc + e]; wu[j][e] = g.convw[j * 5632 + 2816 + gc + e]; }
#pragma unroll
      for (int e = 0; e < 8; ++e) { bg[e] = g.convb[gc + e]; bu[e] = g.convb[2816 + gc + e]; }
      if (tid < 128) {
        int sel = tid >> 5, ch = tid & 31; int lr = sel < 2 ? sel : 252 + sel;
        half_t* dst = (sel < 2 ? g.hf : g.hl) + ((size_t)pm * 2 + (sel & 1)) * 5632 + pn * 256 + ch * 8;
        *(h8*)dst = *(const h8*)(smem + (lr * TS + ch * 8) * 2);
      }
      const bool seq_start = ((brow & (T_ - 1)) == 0);
#pragma unroll 1
      for (int e8 = 0; e8 < 8; ++e8) {
        int id = tid + NTH * e8; int lr = id >> 4;
        long gr = brow + lr;
        if (lr >= 2 || seq_start) {
          int t = (int)(gr & (T_ - 1));
          float m1 = t >= 1 ? 1.f : 0.f, m2 = t >= 2 ? 1.f : 0.f;
          const int lr1 = lr >= 1 ? lr - 1 : 0, lr2 = lr >= 2 ? lr - 2 : 0;
          h8 g0 = *(const h8*)(smem + (lr * TS + cgp * 8) * 2), g1 = *(const h8*)(smem + (lr1 * TS + cgp * 8) * 2), g2 = *(const h8*)(smem + (lr2 * TS + cgp * 8) * 2);
          h8 u0 = *(const h8*)(smem + (lr * TS + 128 + cgp * 8) * 2), u1 = *(const h8*)(smem + (lr1 * TS + 128 + cgp * 8) * 2), u2 = *(const h8*)(smem + (lr2 * TS + 128 + cgp * 8) * 2);
          h8 o;
#pragma unroll
          for (int e = 0; e < 8; ++e) {
            float yg = wg[2][e] * (float)g0[e] + m1 * wg[1][e] * (float)g1[e] + m2 * wg[0][e] * (float)g2[e] + bg[e];
            float yu = wu[2][e] * (float)u0[e] + m1 * wu[1][e] * (float)u1[e] + m2 * wu[0][e] * (float)u2[e] + bu[e];
            o[e] = (half_t)(silu_fast(yg) * yu);
          }
          *(h8*)(g.outh + gr * NFF + gc) = o;
        }
      }
    }
  } else if (EPI == EPI_RES) {
    float* S = (float*)smem;
#pragma unroll 1
    for (int ai = 0; ai < 2; ++ai) {
#pragma unroll
      for (int bj = 0; bj < 2; ++bj) for (int m = 0; m < 4; ++m) for (int n = 0; n < 2; ++n) {
        int row = wr * 64 + m * 16 + fr, col = bj * 128 + wc * 32 + n * 16 + fq * 4;
        f32x4 a = ai ? acc[1][bj][m][n] : acc[0][bj][m][n];
        *(f32x4*)(S + row * 260 + col) = a;
      }
      __syncthreads();
      {
        const long grow0 = brow + ai * 128 + wid * 16;
        h4 rv[16];
#pragma unroll
        for (int rr = 0; rr < 16; ++rr) rv[rr] = *(const h4*)(g.outh + (grow0 + rr) * g.ldo + bcol + lane * 4);
#pragma unroll
        for (int rr = 0; rr < 16; ++rr) {
          f32x4 a = *(const f32x4*)(S + (wid * 16 + rr) * 260 + lane * 4);
          float4 xn; xn.x = (float)rv[rr][0] + a[0]; xn.y = (float)rv[rr][1] + a[1]; xn.z = (float)rv[rr][2] + a[2]; xn.w = (float)rv[rr][3] + a[3];
          if (g.xout) {
            *(float4*)(g.xout + (grow0 + rr) * 1024 + bcol + lane * 4) = xn;
          } else {
            float ss = xn.x * xn.x + xn.y * xn.y + xn.z * xn.z + xn.w * xn.w;
#pragma unroll
            for (int o = 32; o >= 1; o >>= 1) ss += __shfl_xor(ss, o);
            if (lane == 0) g.rss_out[(grow0 + rr) * 4 + pn] = ss;
            h4 v; v[0] = (half_t)xn.x; v[1] = (half_t)xn.y; v[2] = (half_t)xn.z; v[3] = (half_t)xn.w;
            *(h4*)(g.outh + (grow0 + rr) * g.ldo + bcol + lane * 4) = v;
          }
        }
      }
      __syncthreads();
    }
  } else {
    if (tid < 256) { float s = 0.f; for (int kc = 0; kc < 16; ++kc) s += g.c1p[kc * 512 + tid]; aux[tid] = s; }
    __syncthreads();
#pragma unroll
    for (int ai = 0; ai < 2; ++ai) for (int bj = 0; bj < 2; ++bj) for (int m = 0; m < 4; ++m) for (int n = 0; n < 2; ++n) {
      int row = ai * 128 + wr * 64 + m * 16 + fr, col = bj * 128 + wc * 32 + n * 16 + fq * 4;
      f32x4 a = acc[ai][bj][m][n]; h4 v;
#pragma unroll
      for (int j = 0; j < 4; ++j) v[j] = (half_t)siluf(a[j] + aux[col + j]);
      *(h4*)(smem + (row * TS + col) * 2) = v;
    }
    __syncthreads();
    {
      const half_t* tl = (const half_t*)smem;
      const int l32 = lane & 31, hf = lane >> 5;
      f32x16 a2[2];
#pragma unroll
      for (int mt = 0; mt < 2; ++mt)
#pragma unroll
        for (int i = 0; i < 16; ++i) a2[mt][i] = 0.f;
#pragma unroll 4
      for (int s = 0; s < 16; ++s) {
        h8 b = *(const h8*)(tl + (32 * wid + l32) * TS + 16 * s + 8 * hf);
        h8 w0 = *(const h8*)(g.w2t + (l32) * 256 + 16 * s + 8 * hf);
        h8 w1 = *(const h8*)(g.w2t + (32 + l32) * 256 + 16 * s + 8 * hf);
        a2[0] = mfma32(w0, b, a2[0]); a2[1] = mfma32(w1, b, a2[1]);
      }
      const int ci = 32 * wid + l32; const int bgi = pm;
      if (g.kv == 0) {
        float ss = 0.f;
#pragma unroll
        for (int mt = 0; mt < 2; ++mt)
#pragma unroll
          for (int i = 0; i < 16; ++i) ss += a2[mt][i] * a2[mt][i];
        ss += __shfl_xor(ss, 32);
        float rr = rsqrtf(ss * (1.f / 64.f) + EPS);
#pragma unroll
        for (int mt = 0; mt < 2; ++mt)
#pragma unroll
          for (int r = 0; r < 4; ++r) {
            int d0 = 32 * mt + 8 * r + 4 * hf; h4 v;
#pragma unroll
            for (int i = 0; i < 4; ++i) v[i] = (half_t)(a2[mt][4 * r + i] * rr * g.kg0[d0 + i]);
            *(h4*)(g.kc + ((size_t)bgi * 256 + ci) * 64 + d0) = v;
          }
      } else {
#pragma unroll
        for (int mt = 0; mt < 2; ++mt)
#pragma unroll
          for (int rg = 0; rg < 16; ++rg) {
            int d = 32 * mt + crow(rg, hf);
            g.vct[((size_t)(bgi * 4 + (ci >> 6)) * 64 + d) * 64 + (ci & 63)] = (half_t)a2[mt][rg];
          }
      }
    }
  }
  __syncthreads();
}

DI void tile_decode(int t, int nM, int nN, int& pm, int& pn) {
  int per = 16 * nN; int sr = t / per; int rem = t - sr * per;
  int width = nM - sr * 16; if (width > 16) width = 16;
  pn = rem / width; pm = sr * 16 + rem % width;
}

template <int EPI>
__device__ void gemm_phase(const GArgs& g, char* smem) {
  int nt = g.nM * g.nN;
  for (int t = blockIdx.x; t < nt; t += gridDim.x) { int pm, pn; tile_decode(t, g.nM, g.nN, pm, pn); gemm_tile<EPI>(g, pm, pn, smem); }
}

__device__ void phase_prep(const Params& p, int l, char* smem) {
  char* ws = p.ws;
  half_t* proj = (half_t*)(ws + WS_PROJ);
  half_t* kcr = (half_t*)(ws + WS_KCR); half_t* vcr = (half_t*)(ws + WS_VCR);
  half_t* vst = (half_t*)(ws + WS_VST); half_t* vwt = (half_t*)(ws + WS_VWT);
  const float* cs = (const float*)(ws + WS_COS); const float* sn = (const float*)(ws + WS_SIN);
  const int tid = ltid();
  half_t* tl = (half_t*)smem;
  for (int it = blockIdx.x; it < 512; it += gridDim.x) {
    int b = it >> 6, blk = it & 63; long m0 = (long)b * T_ + blk * 64;
    {
      int tok = tid >> 3, sub = tid & 7; long m = m0 + tok; int t = blk * 64 + tok;
      float c8[8], s8[8];
      if (sub < 2) {
#pragma unroll
        for (int i = 0; i < 8; ++i) { c8[i] = cs[m * 8 + i]; s8[i] = sn[m * 8 + i]; }
      }
      h8 uv[14];
#pragma unroll
      for (int u = 0; u < 14; ++u) {
        int col = (u < 8) ? u * 64 : (u < 10 ? 1024 + (u - 8) * 64 : (u < 12 ? 1024 + 256 + (u - 10) * 64 : 1024 + 512 + (u - 12) * 64));
        uv[u] = *(const h8*)(proj + m * PL + col + sub * 8);
      }
      float gq[8], gs[8], gw[8];
#pragma unroll
      for (int i = 0; i < 8; ++i) { gq[i] = p.q_norm[l * 64 + sub * 8 + i]; gs[i] = p.k_norm[(l * 3 + 1) * 64 + sub * 8 + i]; gw[i] = p.k_norm[(l * 3 + 2) * 64 + sub * 8 + i]; }
#pragma unroll
      for (int u = 0; u < 14; ++u) {
        int col = (u < 8) ? u * 64 : (u < 10 ? 1024 + (u - 8) * 64 : (u < 12 ? 1024 + 256 + (u - 10) * 64 : 1024 + 512 + (u - 12) * 64));
        const bool norm = !(u == 8 || u == 9);
        const float scale = (u < 8) ? 0.125f * 1.4426950408889634f : 1.f;
        h8 v = uv[u]; float f[8]; float ss = 0.f;
#pragma unroll
        for (int i = 0; i < 8; ++i) { f[i] = (float)v[i]; ss += f[i] * f[i]; }
        if (norm) {
          ss += __shfl_xor(ss, 1); ss += __shfl_xor(ss, 2); ss += __shfl_xor(ss, 4);
          float r = rsqrtf(ss * (1.f / 64.f) + EPS);
#pragma unroll
          for (int i = 0; i < 8; ++i) f[i] = f[i] * r * (u < 8 ? gq[i] : (u < 12 ? gs[i] : gw[i]));
        }
        float o[8];
#pragma unroll
        for (int i = 0; i < 8; ++i) {
          float other = __shfl_xor(f[i], 1);
          o[i] = f[i];
          if (sub == 0) o[i] = f[i] * c8[i] - other * s8[i];
          else if (sub == 1) o[i] = f[i] * c8[i] + other * s8[i];
          o[i] *= scale;
        }
        h8 w;
#pragma unroll
        for (int i = 0; i < 8; ++i) w[i] = (half_t)o[i];
        if (u == 8 || u == 9) { int g = u - 8; *(h8*)(kcr + ((size_t)(b * 2 + g) * T_ + t) * 64 + sub * 8) = w; }
        else *(h8*)(proj + m * PL + col + sub * 8) = w;
      }
    }
#pragma unroll
    for (int e = 0; e < 2; ++e) {
      int id = tid + NTH * e; int tok = id >> 4, g = (id >> 3) & 1, c8i = id & 7;
      h8 v = *(const h8*)(proj + (m0 + tok) * PL + 1024 + 128 + g * 64 + c8i * 8);
      *(h8*)(vcr + ((size_t)(b * 2 + g) * T_ + blk * 64 + tok) * 64 + c8i * 8) = v;
    }
#pragma unroll 1
    for (int q = 0; q < 4; ++q) {
      int g = q & 1; int col = 1024 + (q < 2 ? 256 : 512) + 128 + g * 64;
      half_t* dst = (q < 2 ? vst : vwt) + ((size_t)((b * 2 + g) * 64 + blk)) * 4096;
      __syncthreads();
      { int tok = tid >> 3, c8i = tid & 7; h8 v = *(const h8*)(proj + (m0 + tok) * PL + col + c8i * 8);
#pragma unroll
        for (int i = 0; i < 8; ++i) tl[tok * 66 + c8i * 8 + i] = v[i]; }
      __syncthreads();
      { int d = tid >> 3, kc = tid & 7; h8 v;
#pragma unroll
        for (int i = 0; i < 8; ++i) v[i] = tl[(kc * 8 + i) * 66 + d];
        *(h8*)(dst + d * 64 + kc * 8) = v; }
    }
    __syncthreads();
  }
}

__device__ void gdn_pre_item(const Params& p, int l, int item, char* smem) {
  char* ws = p.ws;
  const half_t* proj = (const half_t*)(ws + WS_PROJ);
  half_t* WG = (half_t*)p.out; half_t* QG = WG + (size_t)M_ * 512; half_t* UG = QG + (size_t)M_ * 512;
  half_t* KTG = UG + (size_t)M_ * 512; half_t* AQK = (half_t*)(ws + WS_AQK); float* GL = (float*)(ws + WS_GL);
  int tid_ = threadIdx.x; asm volatile("" : "+v"(tid_));
  const int tid = tid_, wid = tid >> 6, lane = tid & 63;
  const int bh = item >> 6, n = item & 63, b = bh >> 2, h = bh & 3;
  const int cid = item; const long m0 = (long)b * T_ + n * 64;
  constexpr int RS = 392;
  half_t* raw = (half_t*)smem;
  float* Akk = (float*)smem; half_t* Th = (half_t*)(smem + 16384); half_t* KtT = (half_t*)(smem + 25600);
  float* TL = (float*)(smem + 44032);
  half_t* Kn = (half_t*)(smem + 61440);
  half_t* Qn = (half_t*)(smem + 78848);
  half_t* Vn = (half_t*)(smem + 96256);
  half_t* VbT = (half_t*)(smem + 113664);
  half_t* KbgT = (half_t*)(smem + 132096);
  float* gv = (float*)(smem + 150528);
  float* gcum = gv; float* beta = gv + 64;

  {
    h8 rv[7];
#pragma unroll
    for (int e = 0; e < 7; ++e) {
      int id = tid + NTH * e; int rr = id / 48, ch = id % 48; int arr = ch >> 4, c8i = ch & 15;
      int t = n * 64 - 3 + rr;
      rv[e] = h8{0, 0, 0, 0, 0, 0, 0, 0};
      if (id < 67 * 48 && t >= 0) rv[e] = *(const h8*)(proj + ((long)b * T_ + t) * PL + 1792 + arr * 512 + h * 128 + c8i * 8);
    }
#pragma unroll
    for (int e = 0; e < 7; ++e) {
      int id = tid + NTH * e; int rr = id / 48, ch = id % 48; int arr = ch >> 4, c8i = ch & 15;
      if (id < 67 * 48) *(h8*)(raw + rr * RS + arr * 128 + c8i * 8) = rv[e];
    }
  }
  if (wid == 0) {
    float a = (float)proj[(m0 + lane) * PL + 3352 + h], bb = (float)proj[(m0 + lane) * PL + 3356 + h];
    float xx = a + p.gdn_dt_bias[l * 4 + h];
    float ey = __expf(-fabsf(xx));
    float l1p = ey < 0.01f ? ey * (1.f - ey * (0.5f - ey * (1.f / 3.f))) : __logf(1.f + ey);
    float sp = fmaxf(xx, 0.f) + l1p;
    float gval = -expf(p.gdn_a_log[l * 4 + h]) * sp;
#pragma unroll
    for (int o = 1; o < 64; o <<= 1) { float y = __shfl_up(gval, o); if (lane >= o) gval += y; }
    gcum[lane] = gval; beta[lane] = sigm(bb);
  }
  __syncthreads();
  const int r = tid >> 3, sub = tid & 7;
  {
    const float* cw = p.gdn_conv_w + (size_t)l * 4 * 1536;
#pragma unroll 1
    for (int arr = 0; arr < 3; ++arr) {
      float y[16]; float ss = 0.f;
#pragma unroll
      for (int e2 = 0; e2 < 16; ++e2) y[e2] = 0.f;
#pragma unroll
      for (int j = 0; j < 4; ++j) {
        const half_t* xr = raw + (r + j) * RS + arr * 128 + sub * 16;
        h8 x0 = *(const h8*)xr, x1 = *(const h8*)(xr + 8);
        const float* wp = cw + j * 1536 + arr * 512 + h * 128 + sub * 16;
        float4 w0 = *(const float4*)wp, w1 = *(const float4*)(wp + 4), w2 = *(const float4*)(wp + 8), w3 = *(const float4*)(wp + 12);
        y[0] += w0.x * (float)x0[0]; y[1] += w0.y * (float)x0[1]; y[2] += w0.z * (float)x0[2]; y[3] += w0.w * (float)x0[3];
        y[4] += w1.x * (float)x0[4]; y[5] += w1.y * (float)x0[5]; y[6] += w1.z * (float)x0[6]; y[7] += w1.w * (float)x0[7];
        y[8] += w2.x * (float)x1[0]; y[9] += w2.y * (float)x1[1]; y[10] += w2.z * (float)x1[2]; y[11] += w2.w * (float)x1[3];
        y[12] += w3.x * (float)x1[4]; y[13] += w3.y * (float)x1[5]; y[14] += w3.z * (float)x1[6]; y[15] += w3.w * (float)x1[7];
      }
#pragma unroll
      for (int e2 = 0; e2 < 16; ++e2) { float a = silu_fast(y[e2]); y[e2] = a; ss += a * a; }
      ss += __shfl_xor(ss, 1); ss += __shfl_xor(ss, 2); ss += __shfl_xor(ss, 4);
      float sc = (arr == 0) ? rsqrtf(ss + EPS) * 0.08838834764831845f : (arr == 1 ? rsqrtf(ss + EPS) : 1.f);
      half_t* dst = (arr == 0) ? Qn : (arr == 1 ? Kn : Vn);
      h8 o0, o1;
#pragma unroll
      for (int e2 = 0; e2 < 8; ++e2) { o0[e2] = (half_t)(y[e2] * sc); o1[e2] = (half_t)(y[8 + e2] * sc); }
      *(h8*)(dst + r * 136 + sub * 16) = o0; *(h8*)(dst + r * 136 + sub * 16 + 8) = o1;
    }
  }
  __syncthreads();
  {
    float gc = gcum[r], bt = beta[r], gl = gcum[63];
    float eg = expf(gc), ek = expf(gl - gc);
    h8 q0, q1;
    h8 kv8[2], vv8[2], qv8[2];
    kv8[0] = *(const h8*)(Kn + r * 136 + sub * 16); kv8[1] = *(const h8*)(Kn + r * 136 + sub * 16 + 8);
    vv8[0] = *(const h8*)(Vn + r * 136 + sub * 16); vv8[1] = *(const h8*)(Vn + r * 136 + sub * 16 + 8);
    qv8[0] = *(const h8*)(Qn + r * 136 + sub * 16); qv8[1] = *(const h8*)(Qn + r * 136 + sub * 16 + 8);
#pragma unroll
    for (int e = 0; e < 16; ++e) {
      int d = sub * 16 + e;
      float kk = (float)kv8[e >> 3][e & 7], vv = (float)vv8[e >> 3][e & 7], qq = (float)qv8[e >> 3][e & 7];
      KbgT[d * 72 + r] = (half_t)(kk * bt * eg);
      VbT[d * 72 + r] = (half_t)(vv * bt);
      KtT[d * 72 + r] = (half_t)(kk * ek);
      half_t qv = (half_t)(qq * eg);
      if (e < 8) q0[e] = qv; else q1[e - 8] = qv;
    }
    *(h8*)(QG + (m0 + r) * 512 + h * 128 + sub * 16) = q0;
    *(h8*)(QG + (m0 + r) * 512 + h * 128 + sub * 16 + 8) = q1;
    if (tid == 0) GL[cid] = expf(gl);
  }
  __syncthreads();
  {
    const int which = wid >> 2, ti = (wid >> 1) & 1, tj = wid & 1, l32 = lane & 31, hf = lane >> 5;
    const half_t* Am = which ? Qn : Kn;
    f32x16 acc;
#pragma unroll
    for (int i = 0; i < 16; ++i) acc[i] = 0.f;
#pragma unroll
    for (int s = 0; s < 8; ++s) {
      h8 a = *(const h8*)(Am + (32 * ti + l32) * 136 + 16 * s + 8 * hf);
      h8 bb = *(const h8*)(Kn + (32 * tj + l32) * 136 + 16 * s + 8 * hf);
      acc = mfma32(a, bb, acc);
    }
    int j = 32 * tj + l32; float gj = gcum[j];
#pragma unroll
    for (int rg = 0; rg < 16; ++rg) {
      int i = 32 * ti + crow(rg, hf); float gi = gcum[i];
      if (which == 0) { float v = (j < i) ? beta[i] * acc[rg] * expf(gi - gj) : 0.f; Akk[i * 64 + j] = v; }
      else { float v = (j <= i) ? acc[rg] * expf(gi - gj) : 0.f; AQK[(size_t)cid * 4096 + i * 64 + j] = (half_t)v; }
    }
#pragma unroll
    for (int e = 0; e < 2; ++e) { int id = tid + NTH * e; int row = id >> 3, c8i = id & 7;
      *(h8*)(KTG + (size_t)cid * 8192 + row * 64 + c8i * 8) = *(const h8*)(KtT + row * 72 + c8i * 8); }
  }
  __syncthreads();
  float* Dg = TL + 64 * 65;
  float* RB = Dg + 1024;
  if (wid == 0) {
    const int blk = lane >> 4, cc = lane & 15;
    float x[16];
#pragma unroll
    for (int ii = 0; ii < 16; ++ii) {
      const float* ar = Akk + (16 * blk + ii) * 64 + 16 * blk;
      f32x4 a0 = *(const f32x4*)ar, a1 = *(const f32x4*)(ar + 4), a2 = *(const f32x4*)(ar + 8), a3 = *(const f32x4*)(ar + 12);
      float av[16] = {a0[0], a0[1], a0[2], a0[3], a1[0], a1[1], a1[2], a1[3], a2[0], a2[1], a2[2], a2[3], a3[0], a3[1], a3[2], a3[3]};
      float a = (ii == cc) ? 1.f : 0.f;
#pragma unroll
      for (int jj = 0; jj < ii; ++jj) a -= av[jj] * x[jj];
      x[ii] = a;
    }
#pragma unroll
    for (int ii = 0; ii < 16; ++ii) Dg[(blk * 16 + ii) * 16 + cc] = x[ii];
  }
  __syncthreads();
#pragma unroll 1
  for (int I = 0; I < 4; ++I) {
    const int il = tid >> 5, c0 = (tid & 31) * 2; const int i = 16 * I + il;
    {
      float a0 = (i == c0) ? 1.f : 0.f, a1 = (i == c0 + 1) ? 1.f : 0.f;
      for (int j = 0; j < 16 * I; ++j) { float av = Akk[i * 64 + j]; a0 -= av * TL[j * 65 + c0]; a1 -= av * TL[j * 65 + c0 + 1]; }
      RB[il * 65 + c0] = a0; RB[il * 65 + c0 + 1] = a1;
    }
    __syncthreads();
    {
      float t0 = 0.f, t1 = 0.f;
#pragma unroll
      for (int k = 0; k < 16; ++k) { float dv = Dg[(I * 16 + il) * 16 + k]; t0 += dv * RB[k * 65 + c0]; t1 += dv * RB[k * 65 + c0 + 1]; }
      TL[i * 65 + c0] = t0; TL[i * 65 + c0 + 1] = t1;
      Th[i * 72 + c0] = (half_t)t0; Th[i * 72 + c0 + 1] = (half_t)t1;
    }
    __syncthreads();
  }
  {
    const int ti = wid >> 2, tj = wid & 3, l32 = lane & 31, hf = lane >> 5;
    f32x16 au, aw;
#pragma unroll
    for (int i = 0; i < 16; ++i) { au[i] = 0.f; aw[i] = 0.f; }
#pragma unroll
    for (int s = 0; s < 4; ++s) {
      h8 a = *(const h8*)(Th + (32 * ti + l32) * 72 + 16 * s + 8 * hf);
      h8 bu = *(const h8*)(VbT + (32 * tj + l32) * 72 + 16 * s + 8 * hf);
      h8 bw = *(const h8*)(KbgT + (32 * tj + l32) * 72 + 16 * s + 8 * hf);
      au = mfma32(a, bu, au); aw = mfma32(a, bw, aw);
    }
#pragma unroll
    for (int rg = 0; rg < 16; ++rg) {
      int i = 32 * ti + crow(rg, hf); int dv = 32 * tj + l32;
      UG[(m0 + i) * 512 + h * 128 + dv] = (half_t)au[rg];
      WG[(m0 + i) * 512 + h * 128 + dv] = (half_t)aw[rg];
    }
  }
  __syncthreads();
}

__device__ void phase_cmp2(const Params& p, int l, char* smem) {
  char* ws = p.ws;
  const half_t* hid = (const half_t*)(ws + WS_HID);
  half_t* KC = (half_t*)(ws + WS_KC); half_t* VCT = (half_t*)(ws + WS_VCT);
  const int tid = ltid();
  half_t* hl = (half_t*)smem;
  float* w2 = (float*)(smem + 64 * 264 * 2);
  for (int it = blockIdx.x; it < 128; it += gridDim.x) {
    int kv = it >> 6, bg = (it >> 2) & 15, Tt = it & 3;
    const half_t* src = hid + ((size_t)kv * 4096 + bg * 256 + Tt * 64) * 256;
#pragma unroll
    for (int e = 0; e < 4; ++e) { int id = tid + NTH * e; int row = id >> 5, c16 = id & 31; *(h8*)(hl + row * 264 + c16 * 8) = *(const h8*)(src + row * 256 + c16 * 8); }
    const float* w2g = p.cmp_w2 + (size_t)(l * 2 + kv) * 256 * 64;
#pragma unroll
    for (int e = 0; e < 8; ++e) { int id = tid + NTH * e; *(float4*)(w2 + id * 4) = *(const float4*)(w2g + id * 4); }
    __syncthreads();
    int r = tid >> 3, dg = tid & 7; float acc[8];
#pragma unroll
    for (int i = 0; i < 8; ++i) acc[i] = 0.f;
    for (int k = 0; k < 256; ++k) {
      float hv = (float)hl[r * 264 + k];
      float4 wa = *(const float4*)(w2 + k * 64 + dg * 8), wb = *(const float4*)(w2 + k * 64 + dg * 8 + 4);
      acc[0] += hv * wa.x; acc[1] += hv * wa.y; acc[2] += hv * wa.z; acc[3] += hv * wa.w;
      acc[4] += hv * wb.x; acc[5] += hv * wb.y; acc[6] += hv * wb.z; acc[7] += hv * wb.w;
    }
    if (kv == 0) {
      float ss = 0.f;
#pragma unroll
      for (int i = 0; i < 8; ++i) ss += acc[i] * acc[i];
      ss += __shfl_xor(ss, 1); ss += __shfl_xor(ss, 2); ss += __shfl_xor(ss, 4);
      float rr = rsqrtf(ss * (1.f / 64.f) + EPS);
      h8 v;
#pragma unroll
      for (int i = 0; i < 8; ++i) v[i] = (half_t)(acc[i] * rr * p.k_norm[(l * 3 + 0) * 64 + dg * 8 + i]);
      *(h8*)(KC + ((size_t)bg * 256 + Tt * 64 + r) * 64 + dg * 8) = v;
    } else {
#pragma unroll
      for (int i = 0; i < 8; ++i) VCT[((size_t)(bg * 4 + Tt) * 64 + dg * 8 + i) * 64 + r] = (half_t)acc[i];
    }
    __syncthreads();
  }
}

constexpr int KVS = 72;
struct NsaCtx {
  const half_t* proj; const half_t* KC; const half_t* VCT; const half_t* VST; const half_t* VWT; const half_t* KST;
  int b, g, qb, bg; int tq; int l32, hf; int tid;
};

template <int MODE>
DI void nsa_branch(const NsaCtx& c, char* smem, int& bufsel, const h8 (&qf)[4], const float shift, float& l_run, f32x16 (&ot)[2],
                   float (&imp)[32], const unsigned* selmask_q, const unsigned* unionmask) {
  const int tid = c.tid;
  const int l32 = c.l32, hf = c.hf;
  const int ql = c.tq & 63;
  int cilim = (c.tq - 31) >> 4; if (cilim > 254) cilim = 254;
  unsigned um0 = 0, um1 = 0, sm0 = 0, sm1 = 0;
  if (MODE == 2) { um0 = unionmask[0]; um1 = unionmask[1]; sm0 = selmask_q[0]; sm1 = selmask_q[1]; }
  int jlo, jhi;
  if (MODE <= 1) { int cnt = 4 * c.qb + 3; if (cnt > 255) cnt = 255; jlo = 0; jhi = (cnt + 63) / 64 - 1; }
  else if (MODE == 2) { jlo = 0; jhi = c.qb; }
  else { jlo = c.qb - 8 < 0 ? 0 : c.qb - 8; jhi = c.qb; }
  auto next_tile = [&](int j) -> int {
    ++j;
    if (MODE == 2) { while (j <= jhi && !(((j < 32 ? um0 >> j : um1 >> (j - 32)) & 1u))) ++j; }
    return j <= jhi ? j : -1;
  };
  h8 kreg[2], vreg[2];
  auto load_regs = [&](int j, h8& kr, h8& vr) {
    int row = tid >> 3, c8i = tid & 7;
    if (MODE <= 1) {
      kr = *(const h8*)(c.KC + ((size_t)c.bg * 256 + j * 64 + row) * 64 + c8i * 8);
      if (MODE == 1) vr = *(const h8*)(c.VCT + (size_t)(c.bg * 4 + j) * 4096 + tid * 8);
    } else {
      int col = 1024 + (MODE == 2 ? 256 : 512) + c.g * 64;
      if (MODE == 2) kr = *(const h8*)(c.KST + (size_t)(c.bg * 64 + j) * 4096 + tid * 8);
      else kr = *(const h8*)(c.proj + ((size_t)c.b * T_ + j * 64 + row) * PL + col + c8i * 8);
      vr = *(const h8*)((MODE == 2 ? c.VST : c.VWT) + (size_t)(c.bg * 64 + j) * 4096 + tid * 8);
    }
  };
  float ylast = 0.f;
  auto compute = [&](int j, const half_t* K, const half_t* V) {
    bool selj = true;
    if (MODE == 2) selj = ((j < 32 ? sm0 >> j : sm1 >> (j - 32)) & 1u) != 0;
    const float init = selj ? -shift : -INFINITY;
    bool need_mask; int lim = 63, lo = 0;
    if (MODE <= 1) { need_mask = true; lim = cilim - 64 * j; }
    else if (MODE == 2) { need_mask = (j == c.qb); lim = ql; }
    else { need_mask = (j == c.qb) || (j == c.qb - 8); if (j == c.qb) lim = ql; else lo = ql + 1; }
    float ps = 0.f;
#pragma unroll
    for (int kt = 0; kt < 2; ++kt) {
      f32x16 st;
      {
        h8 kf[4];
#pragma unroll
        for (int s = 0; s < 4; ++s) kf[s] = *(const h8*)(K + (32 * kt + l32) * KVS + 16 * s + 8 * hf);
#pragma unroll
        for (int i = 0; i < 16; ++i) st[i] = init;
#pragma unroll
        for (int s = 0; s < 4; ++s) st = mfma32(kf[s], qf[s], st);
        __builtin_amdgcn_sched_group_barrier(0x100, 4, 0);
        __builtin_amdgcn_sched_group_barrier(0x008, 4, 0);
      }
      if (need_mask) {
        asm volatile("; boundary tile mask" ::: );
#pragma unroll
        for (int rg = 0; rg < 16; ++rg) {
          int key = 32 * kt + crow(rg, hf);
          st[rg] = (key <= lim && key >= lo) ? st[rg] : -INFINITY;
        }
      }
#pragma unroll
      for (int rg = 0; rg < 16; ++rg) { float pv = EXP2(st[rg]); st[rg] = pv; ps += pv; }
      if (MODE == 1) {
        float y[4];
#pragma unroll
        for (int r = 0; r < 4; ++r) y[r] = __shfl_xor(st[4 * r + 3], 32);
#pragma unroll
        for (int r = 0; r < 4; ++r) {
          float own = st[4 * r] + st[4 * r + 1] + st[4 * r + 2] + st[4 * r + 3];
          float prev = (r > 0) ? y[r - 1] : ylast;
          float carry = hf ? y[r] : prev;
          float add = own + carry;
#pragma unroll
          for (int Tt = 0; Tt < 4; ++Tt) imp[Tt * 8 + kt * 4 + r] += (j == Tt) ? add : 0.f;
        }
        ylast = y[3];
      }
      h8 pf[2];
#pragma unroll
      for (int s2 = 0; s2 < 2; ++s2)
#pragma unroll
        for (int i2 = 0; i2 < 4; ++i2) {
          h2 pr = __builtin_bit_cast(h2, __builtin_amdgcn_cvt_pkrtz(st[8 * s2 + 2 * i2], st[8 * s2 + 2 * i2 + 1]));
          pf[s2][2 * i2] = pr[0]; pf[s2][2 * i2 + 1] = pr[1];
        }
      {
        h8 vf[2][2];
#pragma unroll
        for (int dt = 0; dt < 2; ++dt)
#pragma unroll
          for (int s2 = 0; s2 < 2; ++s2) {
            h4 v0 = *(const h4*)(V + (32 * dt + l32) * KVS + 32 * kt + 16 * s2 + 4 * hf);
            h4 v1 = *(const h4*)(V + (32 * dt + l32) * KVS + 32 * kt + 16 * s2 + 8 + 4 * hf);
            vf[dt][s2] = cat44(v0, v1);
          }
#pragma unroll
        for (int s2 = 0; s2 < 2; ++s2)
#pragma unroll
          for (int dt = 0; dt < 2; ++dt) ot[dt] = mfma32(vf[dt][s2], pf[s2], ot[dt]);
      }
    }
    l_run += ps;
  };
  int ja = next_tile(jlo - 1);
  int jb = ja >= 0 ? next_tile(ja) : -1;
  if (ja >= 0) load_regs(ja, kreg[0], vreg[0]);
  if (jb >= 0) load_regs(jb, kreg[1], vreg[1]);
  while (ja >= 0) {
    char* sb = smem + bufsel * 36864;
    { int row = tid >> 3, c8i = tid & 7;
      *(h8*)((half_t*)(sb) + row * KVS + c8i * 8) = kreg[0];
      if (MODE != 0) *(h8*)((half_t*)(sb + 18432) + row * KVS + c8i * 8) = vreg[0];
      if (jb >= 0) {
        *(h8*)((half_t*)(sb + 9216) + row * KVS + c8i * 8) = kreg[1];
        if (MODE != 0) *(h8*)((half_t*)(sb + 27648) + row * KVS + c8i * 8) = vreg[1];
      } }
    __syncthreads();
    int jc = jb >= 0 ? next_tile(jb) : -1;
    int jd = jc >= 0 ? next_tile(jc) : -1;
    if (jc >= 0) load_regs(jc, kreg[0], vreg[0]);
    if (jd >= 0) load_regs(jd, kreg[1], vreg[1]);
    compute(ja, (const half_t*)sb, (const half_t*)(sb + 18432));
    if (jb >= 0) compute(jb, (const half_t*)(sb + 9216), (const half_t*)(sb + 27648));
    bufsel ^= 1; ja = jc; jb = jd;
  }
}

__device__ void nsa_item(const Params& p, int l, int item, char* smem, int dry = 0) {
  char* ws = p.ws;
  half_t* proj = (half_t*)(ws + WS_PROJ);
  int tid_ = threadIdx.x; asm volatile("" : "+v"(tid_));
  const int tid = tid_, wid = tid >> 6, lane = tid & 63;
  NsaCtx c; c.tid = tid;
  c.proj = proj; c.KC = (const half_t*)(ws + WS_KC); c.VCT = (const half_t*)(ws + WS_VCT);
  c.VST = (const half_t*)(ws + WS_VST); c.VWT = (const half_t*)(ws + WS_VWT); c.KST = (const half_t*)(ws + WS_KST);
  c.qb = 63 - (item >> 4); c.bg = item & 15; c.b = c.bg >> 1; c.g = c.bg & 1;
  c.l32 = lane & 31; c.hf = lane >> 5;
  const int hp = wid >> 1, qhalf = wid & 1, h = c.g * 4 + hp;
  const int ql = 32 * qhalf + c.l32;
  c.tq = c.qb * 64 + ql;
  const long mq = (long)c.b * T_ + c.tq;
  float* impbuf = (float*)(smem + 73728);
  float* seltot = (float*)(smem + 73728 + 65536);
  unsigned* selmask = (unsigned*)(smem + 73728 + 65536 + 16384);
  unsigned* unionmask = selmask + 128;
  h8 qf[4];
#pragma unroll
  for (int s = 0; s < 4; ++s) qf[s] = *(const h8*)(proj + mq * PL + h * 64 + 16 * s + 8 * c.hf);
  float gate[3];
#pragma unroll
  for (int br = 0; br < 3; ++br) gate[br] = sigm((float)proj[mq * PL + 3328 + h * 3 + br]);
  f32x16 outacc[2], ot[2];
#pragma unroll
  for (int dt = 0; dt < 2; ++dt)
#pragma unroll
    for (int i = 0; i < 16; ++i) { outacc[dt][i] = 0.f; ot[dt][i] = 0.f; }
  float imp[32];
#pragma unroll
  for (int i = 0; i < 32; ++i) imp[i] = 0.f;
  int bufsel = 0;
  if (tid < 130) selmask[tid] = 0u;
  float shiftv[3];
  {
    float gq = fabsf(p.q_norm[l * 64 + lane]);
    float g0 = fabsf(p.k_norm[(l * 3 + 0) * 64 + lane]), g1 = fabsf(p.k_norm[(l * 3 + 1) * 64 + lane]), g2 = fabsf(p.k_norm[(l * 3 + 2) * 64 + lane]);
#pragma unroll
    for (int o = 32; o >= 1; o >>= 1) { gq = fmaxf(gq, __shfl_xor(gq, o)); g0 = fmaxf(g0, __shfl_xor(g0, o)); g1 = fmaxf(g1, __shfl_xor(g1, o)); g2 = fmaxf(g2, __shfl_xor(g2, o)); }
    shiftv[0] = fmaxf(0.f, 11.5416f * gq * g0 - 14.f); shiftv[1] = fmaxf(0.f, 11.5416f * gq * g1 - 14.f); shiftv[2] = fmaxf(0.f, 11.5416f * gq * g2 - 14.f);
  }
  float l_run = 0.f;
  nsa_branch<1>(c, smem, bufsel, qf, shiftv[0], l_run, ot, imp, nullptr, nullptr);
  { float lt = l_run + __shfl_xor(l_run, 32); float inv = lt > 0.f ? 1.f / lt : 0.f;
#pragma unroll
    for (int dt = 0; dt < 2; ++dt)
#pragma unroll
      for (int i = 0; i < 16; ++i) { outacc[dt][i] += gate[0] * inv * ot[dt][i]; ot[dt][i] = 0.f; }
#pragma unroll
    for (int i = 0; i < 32; ++i) {
      int Tt = i >> 3, kt = (i >> 2) & 1, r = i & 3;
      impbuf[(hp * 64 + ql) * 64 + 16 * Tt + 8 * kt + 2 * r + c.hf] = imp[i] * inv;
    } }
  __syncthreads();
  {
    int q = tid >> 3, sub = tid & 7; int cur = c.qb;
#pragma unroll
    for (int k = 0; k < 8; ++k) {
      int j = sub + 8 * k;
      float v = impbuf[(0 * 64 + q) * 64 + j] + impbuf[(1 * 64 + q) * 64 + j] + impbuf[(2 * 64 + q) * 64 + j] + impbuf[(3 * 64 + q) * 64 + j];
      if (j == 0 || j == cur || j == cur - 1) v = INFINITY;
      else if (j > cur) v = -INFINITY;
      seltot[q * 64 + j] = v;
    }
  }
  __syncthreads();
  {
    int q = tid >> 3, sub = tid & 7;
    float mine[8]; int rank[8];
#pragma unroll
    for (int k = 0; k < 8; ++k) { mine[k] = seltot[q * 64 + sub + 8 * k]; rank[k] = 0; }
    for (int jj = 0; jj < 64; ++jj) {
      float o = seltot[q * 64 + jj];
#pragma unroll
      for (int k = 0; k < 8; ++k) { int j = sub + 8 * k; rank[k] += (o > mine[k] || (o == mine[k] && jj < j)) ? 1 : 0; }
    }
    unsigned b0 = 0, b1 = 0;
#pragma unroll
    for (int k = 0; k < 8; ++k) { int j = sub + 8 * k; if (rank[k] < 16) { if (j < 32) b0 |= 1u << j; else b1 |= 1u << (j - 32); } }
    if (b0) { atomicOr(&selmask[q * 2], b0); atomicOr(&unionmask[0], b0); }
    if (b1) { atomicOr(&selmask[q * 2 + 1], b1); atomicOr(&unionmask[1], b1); }
  }
  __syncthreads();
  l_run = 0.f;
  nsa_branch<2>(c, smem, bufsel, qf, shiftv[1], l_run, ot, imp, selmask + ql * 2, unionmask);
  { float lt = l_run + __shfl_xor(l_run, 32); float inv = lt > 0.f ? 1.f / lt : 0.f;
#pragma unroll
    for (int dt = 0; dt < 2; ++dt)
#pragma unroll
      for (int i = 0; i < 16; ++i) { outacc[dt][i] += gate[1] * inv * ot[dt][i]; ot[dt][i] = 0.f; } }
  l_run = 0.f;
  nsa_branch<3>(c, smem, bufsel, qf, shiftv[2], l_run, ot, imp, nullptr, nullptr);
  { float lt = l_run + __shfl_xor(l_run, 32); float inv = lt > 0.f ? 1.f / lt : 0.f;
#pragma unroll
    for (int dt = 0; dt < 2; ++dt)
#pragma unroll
      for (int i = 0; i < 16; ++i) outacc[dt][i] += gate[2] * inv * ot[dt][i]; }
  float ss = 0.f;
#pragma unroll
  for (int dt = 0; dt < 2; ++dt)
#pragma unroll
    for (int i = 0; i < 16; ++i) ss += outacc[dt][i] * outacc[dt][i];
  ss += __shfl_xor(ss, 32);
  float rr = rsqrtf(ss * (1.f / 64.f) + EPS);
  int t2 = tid; asm volatile("" : "+v"(t2));
  const int h2 = c.g * 4 + (t2 >> 7);
  const long mq2 = (long)c.b * T_ + c.qb * 64 + 32 * ((t2 >> 6) & 1) + (t2 & 31);
  const float* og = p.nsa_out_norm + (size_t)(l * 8 + h2) * 64;
#pragma unroll
  for (int dt = 0; dt < 2; ++dt)
#pragma unroll
    for (int r = 0; r < 4; ++r) {
      int d0 = 32 * dt + 8 * r + 4 * c.hf; h4 v;
#pragma unroll
      for (int i = 0; i < 4; ++i) v[i] = (half_t)(outacc[dt][4 * r + i] * rr * og[d0 + i]);
      *(h4*)(proj + mq2 * PL + (dry ? 2304 : 0) + h2 * 64 + d0) = v;
    }
  __syncthreads();
}

__device__ void gdn_scan_item(const Params& p, int l, int bh, char* smem, int dry = 0) {
  char* ws = p.ws;
  half_t* proj = (half_t*)(ws + WS_PROJ);
  const half_t* WG = (const half_t*)p.out; const half_t* QG = WG + (size_t)M_ * 512; const half_t* UG = QG + (size_t)M_ * 512;
  const half_t* KTG = UG + (size_t)M_ * 512; const half_t* AQK = (const half_t*)(ws + WS_AQK); const float* GL = (const float*)(ws + WS_GL);
  int tid_ = threadIdx.x; asm volatile("" : "+v"(tid_));
  const int tid = tid_, wid = tid >> 6, lane = tid & 63, l16 = lane & 15, quad = lane >> 4;
  const int b = bh >> 2, h = bh & 3;
  half_t* Wl = (half_t*)smem;
  half_t* Ql = (half_t*)(smem + 17408);
  half_t* Al = (half_t*)(smem + 34816);
  half_t* Ktl = (half_t*)(smem + 44032);
  half_t* Ul = (half_t*)(smem + 62464);
  float* ost = (float*)(smem + 79872);
  f32x4 St[8];
#pragma unroll
  for (int i = 0; i < 8; ++i) St[i] = f32x4{0.f, 0.f, 0.f, 0.f};
  h8 rw[2], rq[2], ru[2], rk[2], ra, rz[2], zc[2]; float egl_next = 0.f;
  auto prefetch = [&](int n) {
    long m0 = (long)b * T_ + n * 64; size_t cid = (size_t)bh * 64 + n;
    { const half_t* zp0 = proj + (m0 + (tid >> 3)) * PL + 512 + h * 128 + (tid & 7) * 16; rz[0] = *(const h8*)zp0; rz[1] = *(const h8*)(zp0 + 8); }
#pragma unroll
    for (int e = 0; e < 2; ++e) {
      int id = tid + NTH * e; int row = id >> 4, c16 = id & 15;
      rw[e] = *(const h8*)(WG + (m0 + row) * 512 + h * 128 + c16 * 8);
      rq[e] = *(const h8*)(QG + (m0 + row) * 512 + h * 128 + c16 * 8);
      ru[e] = *(const h8*)(UG + (m0 + row) * 512 + h * 128 + c16 * 8);
      rk[e] = *(const h8*)(KTG + cid * 8192 + id * 8);
    }
    ra = *(const h8*)(AQK + cid * 4096 + tid * 8);
    { int zoff = 0; asm volatile("" : "+v"(zoff)); egl_next = GL[cid + zoff]; }
  };
  prefetch(0);
  const float* og = p.gdn_out_norm + l * 128;
  for (int n = 0; n < 64; ++n) {
#pragma unroll
    for (int e = 0; e < 2; ++e) {
      int id = tid + NTH * e; int row = id >> 4, c16 = id & 15;
      *(h8*)(Wl + row * 136 + c16 * 8) = rw[e];
      *(h8*)(Ql + row * 136 + c16 * 8) = rq[e];
      *(h8*)(Ul + row * 136 + c16 * 8) = ru[e];
      int krow = id >> 3, kc = id & 7;
      *(h8*)(Ktl + krow * 72 + kc * 8) = rk[e];
    }
    { int row = tid >> 3, kc = tid & 7; *(h8*)(Al + row * 72 + kc * 8) = ra; }
    zc[0] = rz[0]; zc[1] = rz[1];
    const float egl = egl_next;
    __syncthreads();
    if (n + 1 < 64) prefetch(n + 1);
    h8 Sf[4];
#pragma unroll
    for (int s = 0; s < 4; ++s)
#pragma unroll
      for (int i = 0; i < 4; ++i) { Sf[s][i] = (half_t)St[2 * s][i]; Sf[s][4 + i] = (half_t)St[2 * s + 1][i]; }
#define SCHEDB __builtin_amdgcn_sched_barrier(0)
    f32x4 vn[4];
    {
      h8 fa[16]; float uu[16];
#pragma unroll
      for (int ct = 0; ct < 4; ++ct)
#pragma unroll
        for (int s = 0; s < 4; ++s) {
          h4 w0 = *(const h4*)(Wl + (16 * ct + l16) * 136 + 32 * s + 4 * quad);
          h4 w1 = *(const h4*)(Wl + (16 * ct + l16) * 136 + 32 * s + 16 + 4 * quad);
          fa[ct * 4 + s] = cat44(w0, w1);
        }
#pragma unroll
      for (int ct = 0; ct < 4; ++ct)
#pragma unroll
        for (int i = 0; i < 4; ++i) uu[ct * 4 + i] = (float)Ul[(16 * ct + 4 * quad + i) * 136 + 16 * wid + l16];
      SCHEDB;
      {
        f32x4 aa[4];
#pragma unroll
        for (int ct = 0; ct < 4; ++ct) aa[ct] = f32x4{0.f, 0.f, 0.f, 0.f};
#pragma unroll
        for (int s = 0; s < 4; ++s)
#pragma unroll
          for (int ct = 0; ct < 4; ++ct) aa[ct] = mfma16(fa[ct * 4 + s], Sf[s], aa[ct]);
#pragma unroll
        for (int ct = 0; ct < 4; ++ct)
#pragma unroll
          for (int i = 0; i < 4; ++i) vn[ct][i] = uu[ct * 4 + i] - aa[ct][i];
      }
      SCHEDB;
    }
    h8 Vf[2];
#pragma unroll
    for (int s = 0; s < 2; ++s)
#pragma unroll
      for (int i = 0; i < 4; ++i) { Vf[s][i] = (half_t)vn[2 * s][i]; Vf[s][4 + i] = (half_t)vn[2 * s + 1][i]; }
    f32x4 oacc[4];
    {
      h8 fq[16];
#pragma unroll
      for (int ct = 0; ct < 4; ++ct)
#pragma unroll
        for (int s = 0; s < 4; ++s) {
          h4 q0 = *(const h4*)(Ql + (16 * ct + l16) * 136 + 32 * s + 4 * quad);
          h4 q1 = *(const h4*)(Ql + (16 * ct + l16) * 136 + 32 * s + 16 + 4 * quad);
          fq[ct * 4 + s] = cat44(q0, q1);
        }
      SCHEDB;
#pragma unroll
      for (int ct = 0; ct < 4; ++ct) oacc[ct] = f32x4{0.f, 0.f, 0.f, 0.f};
#pragma unroll
      for (int s = 0; s < 4; ++s)
#pragma unroll
        for (int ct = 0; ct < 4; ++ct) oacc[ct] = mfma16(fq[ct * 4 + s], Sf[s], oacc[ct]);
      SCHEDB;
    }
    {
      h8 fb[8];
#pragma unroll
      for (int ct = 0; ct < 4; ++ct)
#pragma unroll
        for (int s = 0; s < 2; ++s) {
          h4 a0 = *(const h4*)(Al + (16 * ct + l16) * 72 + 32 * s + 4 * quad);
          h4 a1 = *(const h4*)(Al + (16 * ct + l16) * 72 + 32 * s + 16 + 4 * quad);
          fb[ct * 2 + s] = cat44(a0, a1);
        }
      SCHEDB;
#pragma unroll
      for (int s = 0; s < 2; ++s)
#pragma unroll
        for (int ct = 0; ct < 4; ++ct) oacc[ct] = mfma16(fb[ct * 2 + s], Vf[s], oacc[ct]);
#pragma unroll
      for (int ct = 0; ct < 4; ++ct)
#pragma unroll
        for (int i = 0; i < 4; ++i) ost[(16 * ct + 4 * quad + i) * 132 + 16 * wid + l16] = oacc[ct][i];
      SCHEDB;
    }
    {
      h8 fk[16];
#pragma unroll
      for (int Tt = 0; Tt < 8; ++Tt)
#pragma unroll
        for (int s = 0; s < 2; ++s) {
          h4 k0 = *(const h4*)(Ktl + (16 * Tt + l16) * 72 + 32 * s + 4 * quad);
          h4 k1 = *(const h4*)(Ktl + (16 * Tt + l16) * 72 + 32 * s + 16 + 4 * quad);
          fk[Tt * 2 + s] = cat44(k0, k1);
        }
      SCHEDB;
#pragma unroll
      for (int Tt = 0; Tt < 8; ++Tt) St[Tt] = St[Tt] * egl;
#pragma unroll
      for (int s = 0; s < 2; ++s)
#pragma unroll
        for (int Tt = 0; Tt < 8; ++Tt) St[Tt] = mfma16(fk[Tt * 2 + s], Vf[s], St[Tt]);
      SCHEDB;
    }
    __syncthreads();
    {
      int r = tid >> 3, seg = tid & 7; long m = (long)b * T_ + n * 64 + r;
      float o[16]; float ss = 0.f;
#pragma unroll
      for (int e = 0; e < 16; ++e) { o[e] = ost[r * 132 + seg * 16 + e]; ss += o[e] * o[e]; }
      ss += __shfl_xor(ss, 1); ss += __shfl_xor(ss, 2); ss += __shfl_xor(ss, 4);
      float rr = rsqrtf(ss * (1.f / 128.f) + EPS);
      half_t* zp = proj + m * PL + 512 + h * 128 + seg * 16;
      h8 z0 = zc[0], z1 = zc[1], o0, o1;
#pragma unroll
      for (int e = 0; e < 8; ++e) {
        o0[e] = (half_t)(o[e] * rr * og[seg * 16 + e] * silu_fast((float)z0[e]));
        o1[e] = (half_t)(o[8 + e] * rr * og[seg * 16 + 8 + e] * silu_fast((float)z1[e]));
      }
      half_t* op = dry ? zp + (1792 - 512) : zp;
      *(h8*)op = o0; *(h8*)(op + 8) = o1;
    }
  }
  __syncthreads();
}

#define XB_TMO      128
#define XB_XCNT(j)  (256  + 64 * (j))
#define XB_XSUB(j)  (1280 + 64 * (j))
#define XB_XGEN(j)  (2304 + 64 * (j))
#define XB_TOP      3328
#define XB_TOPGEN   3392
#define XCD_BAR_WORDS 3456
#define XB_SPIN_CAP (1u << 18)
#define LAS __attribute__((address_space(3)))

__device__ __forceinline__ unsigned xb_ld(unsigned* p)              { return __hip_atomic_load(p, __ATOMIC_RELAXED, __HIP_MEMORY_SCOPE_AGENT); }
__device__ __forceinline__ unsigned xb_add(unsigned* p, unsigned v) { return __hip_atomic_fetch_add(p, v, __ATOMIC_RELAXED, __HIP_MEMORY_SCOPE_AGENT); }
__device__ __forceinline__ unsigned xb_xcc_id() { return (unsigned)__builtin_amdgcn_s_getreg((3 << 11) | 20) & 0xFu; }
#define XB_SPIN(cond, bar) do { unsigned _sp = 0; while (cond) { __builtin_amdgcn_s_sleep(1); \
    if ((++_sp & 255u) == 0u) { if (xb_ld(&(bar)[XB_TMO])) break; if (_sp > XB_SPIN_CAP) { atomicAdd(&(bar)[XB_TMO], 1u); break; } } } } while (0)

struct XcdBarrier {
    unsigned* bar; unsigned x;
    volatile LAS unsigned* st;
};

__device__ __forceinline__ XcdBarrier xcd_barrier_post(unsigned* bar, volatile LAS unsigned* st) {
    XcdBarrier b; b.bar = bar; b.x = xb_xcc_id(); b.st = st;
    if (threadIdx.x == 0) (void)xb_add(&bar[XB_XCNT(b.x)], 1u);
    return b;
}
__device__ __forceinline__ void xcd_barrier_complete(unsigned* bar, unsigned x, unsigned& nloc, unsigned& nx) {
    const unsigned G = gridDim.x * gridDim.y * gridDim.z;
    unsigned sum, cnt, mine, sp = 0u;
    for (;;) {
        sum = 0u; cnt = 0u; mine = 0u;
#pragma unroll
        for (unsigned j = 0; j < 16; ++j) { const unsigned c = xb_ld(&bar[XB_XCNT(j)]); sum += c; cnt += (c > 0u) ? 1u : 0u; mine = (j == x) ? c : mine; }
        if (sum == G) break;
        __builtin_amdgcn_s_sleep(1);
        if ((++sp & 255u) == 0u) { if (xb_ld(&bar[XB_TMO])) break; if (sp > XB_SPIN_CAP) { atomicAdd(&bar[XB_TMO], 1u); break; } }
    }
    nloc = mine > 0u ? mine : 1u; nx = cnt > 0u ? cnt : 1u;
}

__device__ __forceinline__ void xcd_barrier(const XcdBarrier& b) {
    asm volatile("s_waitcnt vmcnt(0)" ::: "memory");
    __syncthreads();
    if (threadIdx.x == 0) {
        unsigned* bar = b.bar;
        __builtin_amdgcn_s_waitcnt(0);
        unsigned nloc = b.st[0], nx = b.st[1];
        if (nloc == 0u) { xcd_barrier_complete(bar, b.x, nloc, nx); b.st[0] = nloc; b.st[1] = nx; }
        const unsigned old = xb_add(&bar[XB_XSUB(b.x)], 1u);
        const unsigned gen = old / nloc;
        if (old + 1u == (gen + 1u) * nloc) {
            __builtin_amdgcn_fence(__ATOMIC_RELEASE, "agent");
            asm volatile("s_waitcnt vmcnt(0)" ::: "memory");
            const unsigned og = xb_add(&bar[XB_TOP], 1u);
            const unsigned tg = og / nx;
            if (og + 1u == (tg + 1u) * nx) xb_add(&bar[XB_TOPGEN], 1u);
            else XB_SPIN(xb_ld(&bar[XB_TOPGEN]) == tg, bar);
            __builtin_amdgcn_fence(__ATOMIC_ACQUIRE, "agent");
            xb_add(&bar[XB_XGEN(b.x)], 1u);
            asm volatile("s_waitcnt vmcnt(0)" ::: "memory");
        } else {
            XB_SPIN(xb_ld(&bar[XB_XGEN(b.x)]) == gen, bar);
            __builtin_amdgcn_fence(__ATOMIC_ACQUIRE, "agent");
            asm volatile("s_waitcnt vmcnt(0)" ::: "memory");
        }
    }
    __syncthreads();
}


DI void grid_barrier(unsigned* cnt, unsigned target) {
  asm volatile("s_waitcnt vmcnt(0) lgkmcnt(0)" ::: "memory");
  __syncthreads();
  if (threadIdx.x == 0) {
    __builtin_amdgcn_fence(__ATOMIC_RELEASE, "agent");
    asm volatile("s_waitcnt vmcnt(0)" ::: "memory");
    __hip_atomic_fetch_add(cnt, 1u, __ATOMIC_RELAXED, __HIP_MEMORY_SCOPE_AGENT);
    while (__hip_atomic_load(cnt, __ATOMIC_RELAXED, __HIP_MEMORY_SCOPE_AGENT) < target) __builtin_amdgcn_s_sleep(1);
    __builtin_amdgcn_fence(__ATOMIC_ACQUIRE, "agent");
    asm volatile("s_waitcnt vmcnt(0) lgkmcnt(0)" ::: "memory");
  }
  __syncthreads();
}

__global__ void __launch_bounds__(NTH, 2) fwd_mega(Params p) {
  extern __shared__ __attribute__((aligned(16))) char smem[];
  cg::grid_group grid = cg::this_grid();
#ifndef PROBE_K
#define PROBE_K -1
#endif
#ifndef PROBE_K2
#define PROBE_K2 -1
#endif
  bool first = true; int repflag = 0; int nbar = 0;
  char* const ws_base = p.ws;
  volatile LAS unsigned* xst = (volatile LAS unsigned*)(smem + LDS_BYTES - 16);
  if (threadIdx.x < 4) xst[threadIdx.x] = 0u;
  __syncthreads();
  XcdBarrier xb = xcd_barrier_post((unsigned*)(p.ws + WS_END), xst);
  for (int ph = p.phase_lo; ph < p.phase_hi;) {
    if (ph % 9 == 2 || ph % 9 == 4 || (ph % 9 == 0 && ph > 0)) { ++ph; continue; }
    if (!first) {
      if (nbar == 0) grid.sync();
      else xcd_barrier(xb);
      ++nbar;
    }
    first = false;
    const int ph_cur = ph;
    {
      const int kk = ph % 9;
      if ((kk == PROBE_K || kk == PROBE_K2) && !repflag && (PROBE_K != 6 || ph < 9)) { repflag = 1; }
      else if (PROBE_K == 15 && kk == 5 && !repflag) { repflag = 1; ph -= 4; }
      else { if (PROBE_K != 15 || kk == 5) repflag = 0; ++ph; }
    }
    { size_t zoffs = 0; asm volatile("" : "+s"(zoffs)); p.ws = ws_base + zoffs; }
    char* ws = p.ws;
    const int l = ph_cur / 9, k = ph_cur % 9;
    if (k == 0) {
      for (int ll = 0; ll < 4; ++ll) phase_weights(p, ll, smem);
    } else if (k == 1) {
      GArgs g{}; g.A = (const half_t*)(ws + WS_XH + 8192); g.lda = 1024; g.Bt = (const half_t*)(ws + wset(l) + WS_WIN); g.K = 1024; g.nM = 128; g.nN = 14;
      g.rss = (const float*)(ws + WS_RSS); g.outh = (half_t*)(ws + WS_PROJ); g.ldo = PL;
      g.cs = (const float*)(ws + WS_COS); g.sn = (const float*)(ws + WS_SIN); g.qg = p.q_norm + l * 64;
      g.kg1 = p.k_norm + (l * 3 + 1) * 64; g.kg2 = p.k_norm + (l * 3 + 2) * 64;
      g.kcr = (half_t*)(ws + WS_KCR); g.vcr = (half_t*)(ws + WS_VCR); g.vst = (half_t*)(ws + WS_VST); g.vwt = (half_t*)(ws + WS_VWT); g.kst = (half_t*)(ws + WS_KST);
      gemm_phase<EPI_IN>(g, smem);
    } else if (k == 3) {
      GArgs g{}; g.lda = 1024; g.K = 2048; g.nM = 16; g.nN = 1; g.ldo = 256;
      for (int it = blockIdx.x; it < 32; it += gridDim.x) {
        int kv = it >> 4, pm = it & 15;
        g.A = (const half_t*)(ws + (kv ? WS_VCR : WS_KCR)); g.Bt = (const half_t*)(ws + wset(l) + WS_WC1) + (size_t)kv * 256 * 2048;
        g.c1p = (const float*)(ws + wset(l) + WS_C1P) + kv * 256; g.kv = kv;
        g.w2t = (const half_t*)(ws + w2t_off(l)) + (size_t)kv * 64 * 256; g.kc = (half_t*)(ws + WS_KC); g.vct = (half_t*)(ws + WS_VCT); g.kg0 = p.k_norm + (l * 3 + 0) * 64;
        gemm_tile<EPI_CMP>(g, pm, 0, smem);
      }
#ifndef NOGDN
      if (blockIdx.x < 32) { for (int it = blockIdx.x * 6; it < blockIdx.x * 6 + 6; ++it) gdn_pre_item(p, l, it, smem); }
      else { for (int it = 192 + (blockIdx.x - 32); it < 2048; it += gridDim.x - 32) gdn_pre_item(p, l, it, smem); }
#endif
    } else if (k == 5) {
#ifndef PROBE_DRY
#define PROBE_DRY 0
#endif
      for (int pass = (PROBE_DRY ? 0 : 1); pass < 2; ++pass) {
        const int dry = (pass == 0);
        if (pass == 1 && PROBE_DRY) grid.sync();
        if (blockIdx.x < 32) { if (!dry || PROBE_DRY == 1) gdn_scan_item(p, l, blockIdx.x, smem, dry); }
        else if (!dry || PROBE_DRY == 2) {
          const int nb = gridDim.x - 32, bi = blockIdx.x - 32;
          for (int r = 0; r * nb < 1024; ++r) { int it = r * nb + ((r & 1) ? nb - 1 - bi : bi); if (it < 1024) nsa_item(p, l, it, smem, dry); }
        }
      }
    } else if (k == 6) {
      GArgs g{}; g.A = (const half_t*)(ws + WS_PROJ); g.lda = PL; g.Bt = (const half_t*)(ws + wset(l) + WS_WOUT); g.K = 1024; g.nM = 128; g.nN = 4;
      g.xout = nullptr; g.rss_out = (float*)(ws + WS_RSS);
      g.outh = (half_t*)(ws + WS_XH + 8192); g.ldo = 1024;
      gemm_phase<EPI_RES>(g, smem);
    } else if (k == 7) {
      GArgs g{}; g.A = (const half_t*)(ws + WS_XH + 8192); g.lda = 1024; g.Bt = (const half_t*)(ws + wset(l) + WS_WUP); g.K = 1024; g.nM = 128; g.nN = 22;
      g.hf = (half_t*)(ws + WS_HF); g.hl = (half_t*)(ws + WS_HL);
      g.rss = (const float*)(ws + WS_RSS); g.outh = (half_t*)(ws + WS_PROJ); g.ldo = NFF;
      g.convw = p.ffn_conv_w + (size_t)l * 3 * 5632; g.convb = p.ffn_conv_b + (size_t)l * 5632;
      gemm_phase<EPI_UP>(g, smem);
    } else {
      GArgs g{}; g.A = (const half_t*)(ws + WS_PROJ); g.lda = NFF; g.Bt = (const half_t*)(ws + wset(l) + WS_WDOWN); g.K = 2816; g.nM = 128; g.nN = 4;
      g.hf = (half_t*)(ws + WS_HF); g.hl = (half_t*)(ws + WS_HL); g.convw = p.ffn_conv_w + (size_t)l * 3 * 5632; g.convb = p.ffn_conv_b + (size_t)l * 5632;
      g.xout = (l < 3) ? nullptr : p.out; g.rss_out = (float*)(ws + WS_RSS);
      g.outh = (half_t*)(ws + WS_XH + 8192); g.ldo = 1024;
      gemm_phase<EPI_RES>(g, smem);
    }
  }
}

extern "C" void kernel_launch(void* const* d_in, const int* in_sizes, int n_in, void* d_out, int out_size, void* d_ws, size_t ws_size,
                              hipStream_t stream) {
  static int grid_blocks = 0;
  if (!grid_blocks) {
    if (ws_size < WS_END + XCD_BAR_WORDS * 4) { fprintf(stderr, "kernel_launch: workspace too small: %zu < %zu\n", ws_size, (size_t)WS_END); grid_blocks = -1; }
    else {
      int dev = 0, cus = 0, per_cu = 0;
      hipGetDevice(&dev);
      hipDeviceGetAttribute(&cus, hipDeviceAttributeMultiprocessorCount, dev);
      hipFuncSetAttribute((const void*)fwd_mega, hipFuncAttributeMaxDynamicSharedMemorySize, LDS_BYTES);
      hipOccupancyMaxActiveBlocksPerMultiprocessor(&per_cu, fwd_mega, NTH, LDS_BYTES);
      if (per_cu < 1) per_cu = 1;
      grid_blocks = cus < 64 ? -1 : cus;
    }
  }
  if (grid_blocks <= 0) return;
  Params p{};
  p.x = (const float*)d_in[0]; p.pos = (const int*)d_in[1]; p.attn_norm = (const float*)d_in[2]; p.w_in = (const float*)d_in[3];
  p.q_norm = (const float*)d_in[4]; p.k_norm = (const float*)d_in[5]; p.cmp_pe = (const float*)d_in[6]; p.cmp_w1 = (const float*)d_in[7];
  p.cmp_w2 = (const float*)d_in[8]; p.nsa_out_norm = (const float*)d_in[9]; p.gdn_conv_w = (const float*)d_in[10];
  p.gdn_a_log = (const float*)d_in[11]; p.gdn_dt_bias = (const float*)d_in[12]; p.gdn_out_norm = (const float*)d_in[13];
  p.w_out = (const float*)d_in[14]; p.ffn_norm = (const float*)d_in[15]; p.w_up = (const float*)d_in[16]; p.ffn_conv_w = (const float*)d_in[17];
  p.ffn_conv_b = (const float*)d_in[18]; p.w_down = (const float*)d_in[19];
  p.out = (float*)d_out; p.ws = (char*)d_ws; p.phase_lo = 0; p.phase_hi = 36;
  (void)hipMemsetAsync((char*)d_ws + WS_END, 0, XCD_BAR_WORDS * 4, stream);
  void* args[] = {&p};
  hipError_t e = hipLaunchCooperativeKernel((void*)fwd_mega, dim3(grid_blocks), dim3(NTH), args, LDS_BYTES, stream);
  if (e != hipSuccess) fprintf(stderr, "cooperative launch failed: %s (grid %d)\n", hipGetErrorString(e), grid_blocks);
}
```
